# Optimizing an MI355X kernel written in HIP

```python
import math
import jax, jax.numpy as jnp
from jax import lax
import numpy as np

D_MODEL = 1024
BATCH = 8
SEQ = 2048
DEPTH = 2

HEAD_DIM = 64
Q_BLOCK = 128
ROPE_THETA = 10000.0
LN_EPS = 1e-5
RMS_EPS = 1e-5
DEEPNORM_ALPHA = (2 * DEPTH) ** 0.25
DEEPNORM_BETA = (8 * DEPTH) ** -0.25

CONV_CH = D_MODEL // 2
CONV_WIDTH = 31
DIFF_VDIM = 2 * HEAD_DIM
DIFF_HEADS = (D_MODEL // 2) // DIFF_VDIM
EVEN_IN = 2 * CONV_CH + DIFF_HEADS * (4 * HEAD_DIM + DIFF_VDIM)
EVEN_MIX = CONV_CH + DIFF_HEADS * DIFF_VDIM

SB_HEADS = (D_MODEL // 2) // HEAD_DIM
SB_WIDTH = SB_HEADS * HEAD_DIM
POOL_WINDOWS = (2, 4, 8, 16)
POOL_GROUPS = len(POOL_WINDOWS)
POOL_CH = (D_MODEL // 2) // POOL_GROUPS
ODD_IN = 3 * SB_WIDTH + POOL_GROUPS * POOL_CH
ODD_MIX = SB_WIDTH + POOL_GROUPS * POOL_CH

N_EXPERTS = 16
N_GROUPS = 4
EXPERTS_PER_GROUP = N_EXPERTS // N_GROUPS
TOP_K = 2
D_FF_EXPERT = 512

kernel_name = 'hybrid_conv_diffattn_stickbreak_pool_moe'


def _layer_norm(x, g, b):
    xf = x.astype(jnp.float32)
    mu = xf.mean(-1, keepdims=True)
    var = jnp.square(xf - mu).mean(-1, keepdims=True)
    y = (xf - mu) * lax.rsqrt(var + LN_EPS)
    return (y * g.astype(jnp.float32) + b.astype(jnp.float32)).astype(x.dtype)


def _rope_tables(n_pos):
    inv = ROPE_THETA ** (-jnp.arange(0, HEAD_DIM, 2, dtype=jnp.float32) / HEAD_DIM)
    ang = jnp.arange(n_pos, dtype=jnp.float32)[:, None] * inv[None, :]
    ang = jnp.concatenate([ang, ang], axis=-1)
    return jnp.cos(ang), jnp.sin(ang)


def _rope(u, cos, sin):
    u1, u2 = jnp.split(u, 2, axis=-1)
    return u * cos + jnp.concatenate([-u2, u1], axis=-1) * sin


def _sweep_query_blocks(block_fn, n_pos):
    return jnp.concatenate(
        [block_fn(i * Q_BLOCK, (i + 1) * Q_BLOCK) for i in range(n_pos // Q_BLOCK)], axis=2)


def _differential_attention(q1, q2, k1, k2, v, lam, lam_init, subln_g):
    scale = HEAD_DIM ** -0.5

    def block(start, end):
        mask = jnp.arange(end)[None, :] <= (start + jnp.arange(Q_BLOCK))[:, None]

        def probs(q, k):
            s = jnp.einsum('bhqd,bhkd->bhqk', q[:, :, start:end], k[:, :, :end]) * scale
            return jax.nn.softmax(jnp.where(mask, s, -jnp.inf), axis=-1)

        w = probs(q1, k1) - lam * probs(q2, k2)
        return jnp.einsum('bhqk,bhkd->bhqd', w, v[:, :, :end])

    o = _sweep_query_blocks(block, q1.shape[2])
    o = o * lax.rsqrt(jnp.mean(jnp.square(o), -1, keepdims=True) + RMS_EPS)
    return o * subln_g.astype(jnp.float32) * (1.0 - lam_init)


def _stick_breaking_attention(q, k, v):
    scale = HEAD_DIM ** -0.5

    def block(start, end):
        mask = jnp.arange(end)[None, :] < (start + jnp.arange(Q_BLOCK))[:, None]
        z = jnp.einsum('bhqd,bhkd->bhqk', q[:, :, start:end], k[:, :, :end]) * scale
        log_stay = jnp.where(mask, jax.nn.log_sigmoid(-z), 0.0)
        suffix = lax.cumsum(log_stay, axis=3, reverse=True) - log_stay
        a = jnp.where(mask, jnp.exp(jax.nn.log_sigmoid(z) + suffix), 0.0)
        return jnp.einsum('bhqk,bhkd->bhqd', a, v[:, :, :end])

    return _sweep_query_blocks(block, q.shape[2])


def _causal_depthwise_conv(u, w, b):
    kern = w[:, None, :].astype(u.dtype)
    y = lax.conv_general_dilated(
        u, kern, window_strides=(1,), padding=[(CONV_WIDTH - 1, 0)],
        dimension_numbers=('NWC', 'WIO', 'NWC'), feature_group_count=u.shape[-1])
    return y + b.astype(u.dtype)


def _multiscale_pool(u, pool_w, pool_scale):
    bsz, n_pos, _ = u.shape
    ug = u.astype(jnp.float32).reshape(bsz, n_pos, POOL_GROUPS, POOL_CH)
    pos = jnp.arange(n_pos)
    outs = []
    for g, win in enumerate(POOL_WINDOWS):
        xg = ug[:, :, g]
        c_pad = jnp.pad(jnp.cumsum(xg, axis=1), ((0, 0), (win, 0), (0, 0)))
        window_sum = c_pad[:, win:] - c_pad[:, :n_pos]
        count = jnp.minimum(pos + 1, win).astype(jnp.float32)
        outs.append(window_sum / count[None, :, None] - xg)
    pooled = jnp.stack(outs, axis=2)
    mixed = jnp.einsum('bsgc,gcd->bsgd', pooled, pool_w.astype(jnp.float32))
    out = mixed.reshape(bsz, n_pos, POOL_GROUPS * POOL_CH) * pool_scale.astype(jnp.float32)
    return out.astype(u.dtype)


def _lambda_init(layer_idx):
    return 0.8 - 0.6 * math.exp(-0.3 * layer_idx)


def _even_mixer(x, in_proj, conv_w, conv_b, conv_ln_g, conv_ln_b,
                lambda_q1, lambda_k1, lambda_q2, lambda_k2, subln_g, out_proj,
                lam_init, cos, sin):
    bsz, n_pos, _ = x.shape
    p = x @ in_proj
    qk_w = DIFF_HEADS * 2 * HEAD_DIM
    a_val, a_gate, dq, dk, dv = jnp.split(
        p, [CONV_CH, 2 * CONV_CH, 2 * CONV_CH + qk_w, 2 * CONV_CH + 2 * qk_w], axis=-1)
    a = a_val * jax.nn.sigmoid(a_gate)
    a = _causal_depthwise_conv(a, conv_w, conv_b)
    a = jax.nn.silu(_layer_norm(a, conv_ln_g, conv_ln_b))
    def split_qk(t):
        return t.reshape(bsz, n_pos, DIFF_HEADS, 2, HEAD_DIM).transpose(3, 0, 2, 1, 4).astype(jnp.float32)
    q = split_qk(dq)
    k = split_qk(dk)
    v = dv.reshape(bsz, n_pos, DIFF_HEADS, DIFF_VDIM).transpose(0, 2, 1, 3).astype(jnp.float32)
    q1, q2 = _rope(q[0], cos, sin), _rope(q[1], cos, sin)
    k1, k2 = _rope(k[0], cos, sin), _rope(k[1], cos, sin)
    f32 = jnp.float32
    lam = (jnp.exp(jnp.sum(lambda_q1.astype(f32) * lambda_k1.astype(f32)))
           - jnp.exp(jnp.sum(lambda_q2.astype(f32) * lambda_k2.astype(f32))) + lam_init)
    o = _differential_attention(q1, q2, k1, k2, v, lam, lam_init, subln_g)
    o = o.transpose(0, 2, 1, 3).reshape(bsz, n_pos, DIFF_HEADS * DIFF_VDIM).astype(x.dtype)
    return jnp.concatenate([a, o], axis=-1) @ out_proj


def _odd_mixer(x, in_proj, pool_w, pool_scale, out_proj):
    bsz, n_pos, _ = x.shape
    p = x @ in_proj
    q, k, v, u = jnp.split(p, [SB_WIDTH, 2 * SB_WIDTH, 3 * SB_WIDTH], axis=-1)

    def heads(t):
        return t.reshape(bsz, n_pos, SB_HEADS, HEAD_DIM).transpose(0, 2, 1, 3).astype(jnp.float32)

    o = _stick_breaking_attention(heads(q), heads(k), heads(v))
    o = o.transpose(0, 2, 1, 3).reshape(bsz, n_pos, SB_WIDTH).astype(x.dtype)
    d = _multiscale_pool(u, pool_w, pool_scale)
    return jnp.concatenate([o, d], axis=-1) @ out_proj


def _grouped_moe(x, router_w, router_bias, w_gate, w_up, w_down):
    bsz, n_pos, dm = x.shape
    t = x.reshape(-1, dm)
    n_tok = t.shape[0]
    affinity = jax.nn.sigmoid(t.astype(jnp.float32) @ router_w.astype(jnp.float32))
    sel = affinity + router_bias.astype(jnp.float32)
    sel_g = sel.reshape(n_tok, N_GROUPS, EXPERTS_PER_GROUP)
    group_score = lax.top_k(sel_g, TOP_K)[0].sum(-1)
    g_best = jnp.argmax(group_score, axis=-1)
    idx = jnp.broadcast_to(g_best[:, None, None], (n_tok, 1, EXPERTS_PER_GROUP))
    in_group = jnp.take_along_axis(sel_g, idx, axis=1)[:, 0]
    _, local = lax.top_k(in_group, TOP_K)
    expert_idx = g_best[:, None] * EXPERTS_PER_GROUP + local
    gate = jnp.take_along_axis(affinity, expert_idx, axis=1)
    gate = gate / gate.sum(-1, keepdims=True)
    combine = (jax.nn.one_hot(expert_idx, N_EXPERTS, dtype=jnp.float32) * gate[..., None]).sum(1)
    h = jax.nn.silu(jnp.einsum('td,edf->tef', t, w_gate)) * jnp.einsum('td,edf->tef', t, w_up)
    h = h * combine[:, :, None].astype(h.dtype)
    y = jnp.einsum('tef,efd->td', h, w_down)
    return y.reshape(bsz, n_pos, dm)


def _normal(key, shape, scale):
    return jax.random.normal(key, shape, jnp.float32) * scale


def setup_inputs(seed: int = 0) -> dict:
    key = jax.random.key(seed)
    ks = iter(jax.random.split(key, 48))
    d = D_MODEL

    def gain(n):
        return 1.0 + _normal(next(ks), (n,), 0.02)

    def bias(n):
        return _normal(next(ks), (n,), 0.01)

    inp = {}
    inp['x'] = _normal(next(ks), (BATCH, SEQ, d), 1.0)
    inp['router_w'] = _normal(next(ks), (d, N_EXPERTS), d ** -0.5)
    inp['router_bias'] = _normal(next(ks), (N_EXPERTS,), 0.01)
    inp['l0_in_proj'] = _normal(next(ks), (d, EVEN_IN), d ** -0.5)
    inp['l0_conv_w'] = _normal(next(ks), (CONV_WIDTH, CONV_CH), CONV_WIDTH ** -0.5)
    inp['l0_conv_b'] = bias(CONV_CH)
    inp['l0_conv_ln_g'] = gain(CONV_CH)
    inp['l0_conv_ln_b'] = bias(CONV_CH)
    inp['l0_lambda_q1'] = _normal(next(ks), (HEAD_DIM,), 0.1)
    inp['l0_lambda_k1'] = _normal(next(ks), (HEAD_DIM,), 0.1)
    inp['l0_lambda_q2'] = _normal(next(ks), (HEAD_DIM,), 0.1)
    inp['l0_lambda_k2'] = _normal(next(ks), (HEAD_DIM,), 0.1)
    inp['l0_subln_g'] = gain(DIFF_VDIM)
    inp['l0_out_proj'] = _normal(next(ks), (EVEN_MIX, d), EVEN_MIX ** -0.5 * DEEPNORM_BETA)
    inp['l0_ln_mix_g'] = gain(d)
    inp['l0_ln_mix_b'] = bias(d)
    inp['l0_w_gate'] = _normal(next(ks), (N_EXPERTS, d, D_FF_EXPERT), d ** -0.5)
    inp['l0_w_up'] = _normal(next(ks), (N_EXPERTS, d, D_FF_EXPERT), d ** -0.5)
    inp['l0_w_down'] = _normal(next(ks), (N_EXPERTS, D_FF_EXPERT, d), D_FF_EXPERT ** -0.5 * DEEPNORM_BETA)
    inp['l0_ln_ffn_g'] = gain(d)
    inp['l0_ln_ffn_b'] = bias(d)
    inp['l1_in_proj'] = _normal(next(ks), (d, ODD_IN), d ** -0.5)
    inp['l1_pool_w'] = _normal(next(ks), (POOL_GROUPS, POOL_CH, POOL_CH), POOL_CH ** -0.5)
    inp['l1_pool_scale'] = 1.0 + _normal(next(ks), (POOL_GROUPS * POOL_CH,), 0.1)
    inp['l1_out_proj'] = _normal(next(ks), (ODD_MIX, d), ODD_MIX ** -0.5 * DEEPNORM_BETA)
    inp['l1_ln_mix_g'] = gain(d)
    inp['l1_ln_mix_b'] = bias(d)
    inp['l1_w_gate'] = _normal(next(ks), (N_EXPERTS, d, D_FF_EXPERT), d ** -0.5)
    inp['l1_w_up'] = _normal(next(ks), (N_EXPERTS, d, D_FF_EXPERT), d ** -0.5)
    inp['l1_w_down'] = _normal(next(ks), (N_EXPERTS, D_FF_EXPERT, d), D_FF_EXPERT ** -0.5 * DEEPNORM_BETA)
    inp['l1_ln_ffn_g'] = gain(d)
    inp['l1_ln_ffn_b'] = bias(d)
    return inp


def reference(x, router_w, router_bias,
              l0_in_proj, l0_conv_w, l0_conv_b, l0_conv_ln_g, l0_conv_ln_b,
              l0_lambda_q1, l0_lambda_k1, l0_lambda_q2, l0_lambda_k2, l0_subln_g,
              l0_out_proj, l0_ln_mix_g, l0_ln_mix_b, l0_w_gate, l0_w_up, l0_w_down,
              l0_ln_ffn_g, l0_ln_ffn_b,
              l1_in_proj, l1_pool_w, l1_pool_scale, l1_out_proj, l1_ln_mix_g, l1_ln_mix_b,
              l1_w_gate, l1_w_up, l1_w_down, l1_ln_ffn_g, l1_ln_ffn_b):
    cos, sin = _rope_tables(x.shape[1])
    mixer_params = [
        (l0_in_proj, l0_conv_w, l0_conv_b, l0_conv_ln_g, l0_conv_ln_b,
         l0_lambda_q1, l0_lambda_k1, l0_lambda_q2, l0_lambda_k2, l0_subln_g, l0_out_proj),
        (l1_in_proj, l1_pool_w, l1_pool_scale, l1_out_proj),
    ]
    mix_norms = [(l0_ln_mix_g, l0_ln_mix_b), (l1_ln_mix_g, l1_ln_mix_b)]
    experts = [(l0_w_gate, l0_w_up, l0_w_down), (l1_w_gate, l1_w_up, l1_w_down)]
    ffn_norms = [(l0_ln_ffn_g, l0_ln_ffn_b), (l1_ln_ffn_g, l1_ln_ffn_b)]
    for i in range(DEPTH):
        if i % 2 == 0:
            mix = _even_mixer(x, *mixer_params[i], lam_init=_lambda_init(i), cos=cos, sin=sin)
        else:
            mix = _odd_mixer(x, *mixer_params[i])
        x = _layer_norm(DEEPNORM_ALPHA * x + mix, *mix_norms[i])
        ffn = _grouped_moe(x, router_w, router_bias, *experts[i])
        x = _layer_norm(DEEPNORM_ALPHA * x + ffn, *ffn_norms[i])
    return x
```

```cpp
#include <hip/hip_runtime.h>
#include <cstdint>
#include <cstdio>

typedef unsigned short bf16_t;

constexpr int T_TOK = 16384, DM = 1024, SEQ = 2048, NB = 8;
constexpr int NE = 16, DFF = 512;
constexpr float ALPHA = 1.41421356237f;
constexpr float LN_EPS = 1e-5f, RMS_EPS = 1e-5f;
constexpr float LOG2E = 1.4426950408889634f;
constexpr float QSCALE = 0.125f * LOG2E;
constexpr float LAM_INIT0 = 0.2f;

constexpr size_t MiB = 1u << 20;
constexpr size_t WS_CTL = 0;
constexpr size_t WS_ROPE = 1 * MiB;
constexpr size_t WS_TOPK = 2 * MiB;
constexpr size_t WS_LTOK = 3 * MiB;
constexpr size_t WS_LGATE = 4 * MiB;
constexpr size_t WS_WFOLD = 243 * MiB;
constexpr size_t WS_WT = 6 * MiB;
constexpr size_t WS_XB = 115 * MiB;
constexpr size_t WS_PBUF = 147 * MiB;
constexpr size_t WS_MIX = 211 * MiB;
constexpr size_t WS_X1B = 243 * MiB;
constexpr size_t WS_END = 275 * MiB;

constexpr int CW_CNT = 64;

__device__ __forceinline__ float bf2f(bf16_t v) { return __uint_as_float(((unsigned)v) << 16); }
__device__ __forceinline__ bf16_t f2bf(float f) { unsigned u = __float_as_uint(f); return (bf16_t)((u + 0x7fffu + ((u >> 16) & 1u)) >> 16); }
__device__ __forceinline__ float sigmoidf_(float x) { return 1.0f / (1.0f + __expf(-x)); }
__device__ __forceinline__ float wave_sum(float v) {
#pragma unroll
    for (int o = 1; o < 64; o <<= 1) v += __shfl_xor(v, o);
    return v;
}

__global__ void k_cvt_bf16(const float* __restrict__ x, bf16_t* __restrict__ o, size_t n) {
    size_t i = (size_t)blockIdx.x * blockDim.x + threadIdx.x;
    if (i < n) o[i] = f2bf(x[i]);
}
__global__ void k_rope_table(float2* cs) {
    int i = blockIdx.x * blockDim.x + threadIdx.x; if (i >= SEQ * 32) return;
    int pos = i / 32, f = i % 32;
    float inv = powf(10000.0f, -(float)(2 * f) / 64.0f);
    float ang = (float)pos * inv;
    float s, c; sincosf(ang, &s, &c);
    cs[i] = make_float2(c, s);
}

template <bool PAIR, class Epi>
__global__ __launch_bounds__(256) void k_gemm_naive(const bf16_t* __restrict__ A, int lda, const float* __restrict__ W, int ldw, int K, Epi epi) {
    __shared__ float As[16][65];
    __shared__ float Wa[16][65];
    __shared__ float Wb[16][65];
    const int tid = threadIdx.x, tx = tid & 15, ty = tid >> 4;
    const int m0 = blockIdx.y * 64, j0 = blockIdx.x * 64;
    float accA[4][4], accB[4][4];
#pragma unroll
    for (int i = 0; i < 4; ++i)
#pragma unroll
        for (int j = 0; j < 4; ++j) { accA[i][j] = 0.f; accB[i][j] = 0.f; }
    for (int k0 = 0; k0 < K; k0 += 16) {
        for (int i = tid; i < 1024; i += 256) { int r = i >> 4, kk = i & 15; As[kk][r] = bf2f(A[(size_t)(m0 + r) * lda + k0 + kk]); }
        for (int i = tid; i < 1024; i += 256) { int kk = i >> 6, jj = i & 63;
            Wa[kk][jj] = W[(size_t)(k0 + kk) * ldw + epi.colA(j0 + jj)];
            if (PAIR) Wb[kk][jj] = W[(size_t)(k0 + kk) * ldw + epi.colB(j0 + jj)]; }
        __syncthreads();
#pragma unroll
        for (int kk = 0; kk < 16; ++kk) {
            float a[4], b[4], c[4];
#pragma unroll
            for (int i = 0; i < 4; ++i) a[i] = As[kk][ty * 4 + i];
#pragma unroll
            for (int j = 0; j < 4; ++j) { b[j] = Wa[kk][tx * 4 + j]; c[j] = PAIR ? Wb[kk][tx * 4 + j] : 0.f; }
#pragma unroll
            for (int i = 0; i < 4; ++i)
#pragma unroll
                for (int j = 0; j < 4; ++j) { accA[i][j] += a[i] * b[j]; if (PAIR) accB[i][j] += a[i] * c[j]; }
        }
        __syncthreads();
    }
#pragma unroll
    for (int i = 0; i < 4; ++i)
#pragma unroll
        for (int j = 0; j < 4; ++j) epi.store(m0 + ty * 4 + i, j0 + tx * 4 + j, accA[i][j], accB[i][j]);
}

struct EpiIn0 {
    bf16_t* pbuf; const float2* cs;
    __device__ int colA(int j) const { if (j < 512) return j; if (j < 1024) return 1024 + (j - 512); if (j < 1536) return 1536 + (j - 1024); return 2048 + (j - 1536); }
    __device__ int colB(int j) const { if (j < 512) return 512 + j; if (j < 1024) return 1024 + ((j - 512) ^ 32); if (j < 1536) return 1536 + ((j - 1024) ^ 32); return 2048 + (j - 1536); }
    __device__ void store(int m, int j, float a, float b) const {
        const int reg = j >> 9, jj = j & 511; float o;
        if (reg == 0) o = a * sigmoidf_(b);
        else if (reg == 3) o = a;
        else { const int d = jj & 63, pos = m & (SEQ - 1); const float2 c = cs[pos * 32 + (d & 31)];
            o = (d < 32) ? a * c.x - b * c.y : a * c.x + b * c.y; if (reg == 1) o *= QSCALE; }
        pbuf[(size_t)reg * T_TOK * 512 + (size_t)m * 512 + jj] = f2bf(o);
    }
};
struct EpiIn1 {
    bf16_t* p1;
    __device__ int colA(int j) const { return j; }
    __device__ int colB(int j) const { return j; }
    __device__ void store(int m, int j, float a, float) const { p1[(size_t)m * 2048 + j] = f2bf(j < 512 ? a * QSCALE : a); }
};
struct EpiOut {
    bf16_t* y; const bf16_t* xb;
    __device__ int colA(int j) const { return j; }
    __device__ int colB(int j) const { return j; }
    __device__ void store(int m, int j, float a, float) const { y[(size_t)m * DM + j] = f2bf(ALPHA * bf2f(xb[(size_t)m * DM + j]) + a); }
};

__global__ __launch_bounds__(512) void k_conv_naive(const bf16_t* __restrict__ aglu, const float* __restrict__ cw, const float* __restrict__ cb,
                                                   const float* __restrict__ g, const float* __restrict__ b, bf16_t* __restrict__ mix) {
    __shared__ float red[16];
    const int t = blockIdx.x, c = threadIdx.x, pos = t & (SEQ - 1);
    float acc = cb[c];
    for (int w = 0; w < 31; ++w) { const int p = pos - 30 + w; if (p >= 0) acc += bf2f(aglu[(size_t)(t - 30 + w) * 512 + c]) * cw[w * 512 + c]; }
    float s = wave_sum(acc);
    if ((c & 63) == 0) red[c >> 6] = s;
    __syncthreads();
    float tot = 0.f;
    for (int i = 0; i < 8; ++i) tot += red[i];
    const float mean = tot * (1.0f / 512.0f), d = acc - mean;
    float q = wave_sum(d * d);
    if ((c & 63) == 0) red[8 + (c >> 6)] = q;
    __syncthreads();
    float tq = 0.f;
    for (int i = 0; i < 8; ++i) tq += red[8 + i];
    const float rstd = rsqrtf(tq * (1.0f / 512.0f) + LN_EPS);
    const float y = d * rstd * g[c] + b[c];
    mix[(size_t)t * DM + c] = f2bf(y * sigmoidf_(y));
}

__global__ __launch_bounds__(256) void k_diffattn_naive(const bf16_t* __restrict__ Q, const bf16_t* __restrict__ Kt, const bf16_t* __restrict__ V, bf16_t* __restrict__ obuf) {
    __shared__ float Qs[32][65];
    __shared__ float Ks[32][65];
    __shared__ float Vs[32][129];
    __shared__ float Ps[32][33];
    const int tid = threadIdx.x, tx = tid & 7, ty = tid >> 3;
    const int qb = blockIdx.x, bh = blockIdx.y, st = blockIdx.z, b = bh >> 2, h = bh & 3;
    const size_t row0 = (size_t)b * SEQ;
    const int q0 = qb * 32, colqk = h * 128 + st * 64, colv = h * 128;
    for (int i = tid; i < 32 * 64; i += 256) { int r = i >> 6, d = i & 63; Qs[r][d] = bf2f(Q[(row0 + q0 + r) * 512 + colqk + d]); }
    float m = -INFINITY, l = 0.f, o[16];
#pragma unroll
    for (int c = 0; c < 16; ++c) o[c] = 0.f;
    const int qrow = q0 + ty;
    for (int j0 = 0; j0 <= q0; j0 += 32) {
        __syncthreads();
        for (int i = tid; i < 32 * 64; i += 256) { int r = i >> 6, d = i & 63; Ks[r][d] = bf2f(Kt[(row0 + j0 + r) * 512 + colqk + d]); }
        for (int i = tid; i < 32 * 128; i += 256) { int r = i >> 7, d = i & 127; Vs[r][d] = bf2f(V[(row0 + j0 + r) * 512 + colv + d]); }
        __syncthreads();
        float s[4], mx = -INFINITY;
#pragma unroll
        for (int i = 0; i < 4; ++i) { const int kk = tx + 8 * i; float a = 0.f;
            for (int d = 0; d < 64; ++d) a += Qs[ty][d] * Ks[kk][d];
            if (j0 + kk > qrow) a = -INFINITY; s[i] = a; mx = fmaxf(mx, a); }
        mx = fmaxf(mx, __shfl_xor(mx, 1)); mx = fmaxf(mx, __shfl_xor(mx, 2)); mx = fmaxf(mx, __shfl_xor(mx, 4));
        const float mn = fmaxf(m, mx), alpha = exp2f(m - mn);
        float ps = 0.f;
#pragma unroll
        for (int i = 0; i < 4; ++i) { const float p = exp2f(s[i] - mn); ps += p; Ps[ty][tx + 8 * i] = p; }
        ps += __shfl_xor(ps, 1); ps += __shfl_xor(ps, 2); ps += __shfl_xor(ps, 4);
        l = l * alpha + ps; m = mn;
        __syncthreads();
#pragma unroll
        for (int c = 0; c < 16; ++c) { const int d = tx + 8 * c; float a = o[c] * alpha;
            for (int kk = 0; kk < 32; ++kk) a += Ps[ty][kk] * Vs[kk][d];
            o[c] = a; }
    }
    const float il = 1.0f / l;
#pragma unroll
    for (int c = 0; c < 16; ++c) obuf[(size_t)st * T_TOK * 512 + (row0 + qrow) * 512 + colv + tx + 8 * c] = f2bf(o[c] * il);
}
__global__ __launch_bounds__(512) void k_diffcombine_naive(const bf16_t* __restrict__ obuf, const float* lq1, const float* lk1, const float* lq2, const float* lk2,
                                                          const float* __restrict__ sg, bf16_t* __restrict__ mix) {
    const int t = blockIdx.x, c = threadIdx.x, lane = c & 63;
    const float d1 = wave_sum(lq1[lane] * lk1[lane]), d2 = wave_sum(lq2[lane] * lk2[lane]);
    const float lam = expf(d1) - expf(d2) + LAM_INIT0;
    const float o = bf2f(obuf[(size_t)t * 512 + c]) - lam * bf2f(obuf[(size_t)T_TOK * 512 + (size_t)t * 512 + c]);
    float ss = wave_sum(o * o);
    __shared__ float red[8];
    if (lane == 0) red[c >> 6] = ss;
    __syncthreads();
    const int hw = (c >> 7) * 2;
    const float tot = red[hw] + red[hw + 1];
    const float r = rsqrtf(tot * (1.0f / 128.0f) + RMS_EPS);
    mix[(size_t)t * DM + 512 + c] = f2bf(o * r * sg[c & 127] * (1.0f - LAM_INIT0));
}

__global__ __launch_bounds__(256) void k_sbattn_naive(const bf16_t* __restrict__ P1, bf16_t* __restrict__ mix) {
    __shared__ float Qs[32][65];
    __shared__ float Ks[32][65];
    __shared__ float Vs[32][65];
    __shared__ float Ps[32][33];
    const int tid = threadIdx.x, tx = tid & 7, ty = tid >> 3;
    const int qb = blockIdx.x, bh = blockIdx.y, b = bh >> 3, h = bh & 7;
    const size_t row0 = (size_t)b * SEQ;
    const int q0 = qb * 32;
    for (int i = tid; i < 32 * 64; i += 256) { int r = i >> 6, d = i & 63; Qs[r][d] = bf2f(P1[(row0 + q0 + r) * 2048 + h * 64 + d]); }
    float carry = 0.f, o[8];
#pragma unroll
    for (int c = 0; c < 8; ++c) o[c] = 0.f;
    const int qrow = q0 + ty;
    for (int j0 = q0; j0 >= 0; j0 -= 32) {
        __syncthreads();
        for (int i = tid; i < 32 * 64; i += 256) { int r = i >> 6, d = i & 63;
            Ks[r][d] = bf2f(P1[(row0 + j0 + r) * 2048 + 512 + h * 64 + d]); Vs[r][d] = bf2f(P1[(row0 + j0 + r) * 2048 + 1024 + h * 64 + d]); }
        __syncthreads();
        float ls[4], lb[4]; bool ok[4]; float tsum = 0.f;
#pragma unroll
        for (int i = 0; i < 4; ++i) { const int kk = tx * 4 + i; float z = 0.f;
            for (int d = 0; d < 64; ++d) z += Qs[ty][d] * Ks[kk][d];
            ok[i] = (j0 + kk) < qrow;
            const float sp = fmaxf(z, 0.f) + log2f(1.0f + exp2f(-fabsf(z)));
            ls[i] = ok[i] ? -sp : 0.f; lb[i] = z - sp; tsum += ls[i]; }
        float R = tsum;
        { float v = __shfl_down(R, 1); if (tx + 1 < 8) R += v; }
        { float v = __shfl_down(R, 2); if (tx + 2 < 8) R += v; }
        { float v = __shfl_down(R, 4); if (tx + 4 < 8) R += v; }
        const float tile_total = __shfl(R, (tid & 63) & ~7);
        float suf = carry + (R - tsum);
#pragma unroll
        for (int i = 3; i >= 0; --i) { const float a = ok[i] ? exp2f(lb[i] + suf) : 0.f; Ps[ty][tx * 4 + i] = a; suf += ls[i]; }
        carry += tile_total;
        __syncthreads();
#pragma unroll
        for (int c = 0; c < 8; ++c) { const int d = tx + 8 * c; float a = o[c];
            for (int kk = 0; kk < 32; ++kk) a += Ps[ty][kk] * Vs[kk][d];
            o[c] = a; }
    }
#pragma unroll
    for (int c = 0; c < 8; ++c) mix[(row0 + qrow) * DM + h * 64 + tx + 8 * c] = f2bf(o[c]);
}

__global__ void k_pool_naive(const bf16_t* __restrict__ P1, bf16_t* __restrict__ mix) {
    const size_t i = (size_t)blockIdx.x * blockDim.x + threadIdx.x; if (i >= (size_t)T_TOK * 512) return;
    const int t = (int)(i >> 9), c = (int)(i & 511), g = c >> 7, win = 2 << g, pos = t & (SEQ - 1);
    const int cnt = (pos + 1 < win) ? pos + 1 : win;
    float s = 0.f;
    for (int k = 0; k < cnt; ++k) s += bf2f(P1[(size_t)(t - k) * 2048 + 1536 + c]);
    const float u = bf2f(P1[(size_t)t * 2048 + 1536 + c]);
    mix[(size_t)t * DM + 512 + c] = f2bf(s / (float)cnt - u);
}
__global__ void k_fold_naive(const float* __restrict__ op, const float* __restrict__ pw, const float* __restrict__ ps, float* __restrict__ wf) {
    const int i = blockIdx.x * blockDim.x + threadIdx.x; if (i >= 1024 * 1024) return;
    const int r = i >> 10, n = i & 1023;
    if (r < 512) { wf[i] = op[i]; return; }
    const int g = (r - 512) >> 7, c = (r - 512) & 127;
    float a = 0.f;
    for (int d = 0; d < 128; ++d) a += pw[(g * 128 + c) * 128 + d] * ps[g * 128 + d] * op[(size_t)(512 + g * 128 + d) * 1024 + n];
    wf[i] = a;
}

__global__ __launch_bounds__(256) void k_ln_router_naive(const bf16_t* __restrict__ Y, const float* __restrict__ g, const float* __restrict__ bta,
                                                         const float* __restrict__ rw, const float* __restrict__ rb, bf16_t* __restrict__ x1b,
                                                         int4* __restrict__ topk, int* __restrict__ ltok, float* __restrict__ lgate, int* __restrict__ cnt) {
    const int lane = threadIdx.x & 63, t = blockIdx.x * 4 + (threadIdx.x >> 6);
    float v[16], s = 0.f;
#pragma unroll
    for (int i = 0; i < 16; ++i) { v[i] = bf2f(Y[(size_t)t * DM + lane + 64 * i]); s += v[i]; }
    const float mean = wave_sum(s) * (1.0f / DM);
    float q = 0.f;
#pragma unroll
    for (int i = 0; i < 16; ++i) { v[i] -= mean; q += v[i] * v[i]; }
    const float rstd = rsqrtf(wave_sum(q) * (1.0f / DM) + LN_EPS);
    float lg[16];
#pragma unroll
    for (int e = 0; e < 16; ++e) lg[e] = 0.f;
#pragma unroll
    for (int i = 0; i < 16; ++i) { const int c = lane + 64 * i; const float y = v[i] * rstd * g[c] + bta[c];
        x1b[(size_t)t * DM + c] = f2bf(y);
#pragma unroll
        for (int e = 0; e < 16; ++e) lg[e] += y * rw[c * 16 + e]; }
#pragma unroll
    for (int e = 0; e < 16; ++e) lg[e] = wave_sum(lg[e]);
    if (lane == 0) {
        float aff[16], sel[16];
#pragma unroll
        for (int e = 0; e < 16; ++e) { aff[e] = 1.0f / (1.0f + expf(-lg[e])); sel[e] = aff[e] + rb[e]; }
        int gb = 0, bi1 = 0, bi2 = 1; float best = -INFINITY;
#pragma unroll
        for (int gi = 0; gi < 4; ++gi) {
            int i1 = 0; float v1 = sel[gi * 4];
#pragma unroll
            for (int k = 1; k < 4; ++k) if (sel[gi * 4 + k] > v1) { v1 = sel[gi * 4 + k]; i1 = k; }
            int i2 = -1; float v2 = -INFINITY;
#pragma unroll
            for (int k = 0; k < 4; ++k) if (k != i1 && sel[gi * 4 + k] > v2) { v2 = sel[gi * 4 + k]; i2 = k; }
            const float sc = v1 + v2;
            if (sc > best) { best = sc; gb = gi; bi1 = i1; bi2 = i2; }
        }
        const int e0 = gb * 4 + bi1, e1 = gb * 4 + bi2;
        float a0 = 0.f, a1 = 0.f;
#pragma unroll
        for (int e = 0; e < 16; ++e) { if (e == e0) a0 = aff[e]; if (e == e1) a1 = aff[e]; }
        const float g0 = a0 / (a0 + a1), g1 = a1 / (a0 + a1);
        topk[t] = make_int4(e0, e1, __float_as_int(g0), __float_as_int(g1));
        const int s0 = atomicAdd(&cnt[e0], 1); ltok[e0 * T_TOK + s0] = t * 2 + 0; lgate[e0 * T_TOK + s0] = g0;
        const int s1 = atomicAdd(&cnt[e1], 1); ltok[e1 * T_TOK + s1] = t * 2 + 1; lgate[e1 * T_TOK + s1] = g1;
    }
}

__global__ __launch_bounds__(256) void k_moe_naive(const bf16_t* __restrict__ x1b, const int4* __restrict__ topk, const float* __restrict__ wg, const float* __restrict__ wu,
                                                   const float* __restrict__ wd, bf16_t* __restrict__ ys0, bf16_t* __restrict__ ys1) {
    __shared__ float xs[DM];
    __shared__ float hs[DFF];
    const int t = blockIdx.x, tid = threadIdx.x;
    for (int i = tid; i < DM; i += 256) xs[i] = bf2f(x1b[(size_t)t * DM + i]);
    const int4 tk = topk[t];
    for (int k = 0; k < 2; ++k) {
        const int e = k ? tk.y : tk.x; const float gate = __int_as_float(k ? tk.w : tk.z);
        __syncthreads();
        const float* G = wg + (size_t)e * DM * DFF; const float* U = wu + (size_t)e * DM * DFF;
        float g0 = 0.f, g1 = 0.f, u0 = 0.f, u1 = 0.f;
        for (int d = 0; d < DM; ++d) { const float x = xs[d]; g0 += x * G[(size_t)d * DFF + tid]; g1 += x * G[(size_t)d * DFF + tid + 256];
            u0 += x * U[(size_t)d * DFF + tid]; u1 += x * U[(size_t)d * DFF + tid + 256]; }
        hs[tid] = g0 * sigmoidf_(g0) * u0 * gate; hs[tid + 256] = g1 * sigmoidf_(g1) * u1 * gate;
        __syncthreads();
        const float* Dw = wd + (size_t)e * DFF * DM;
        float y[4] = {0.f, 0.f, 0.f, 0.f};
        for (int f = 0; f < DFF; ++f) { const float hv = hs[f];
#pragma unroll
            for (int i = 0; i < 4; ++i) y[i] += hv * Dw[(size_t)f * DM + tid + 256 * i]; }
        bf16_t* ys = k ? ys1 : ys0;
#pragma unroll
        for (int i = 0; i < 4; ++i) ys[(size_t)t * DM + tid + 256 * i] = f2bf(y[i]);
    }
}

__global__ __launch_bounds__(256) void k_ln_ffn_naive(const bf16_t* x1b, const bf16_t* ys0, const bf16_t* ys1, const float* __restrict__ g,
                                                      const float* __restrict__ bta, bf16_t* xb_out, float* fout) {
    const int lane = threadIdx.x & 63, t = blockIdx.x * 4 + (threadIdx.x >> 6);
    float v[16], s = 0.f;
#pragma unroll
    for (int i = 0; i < 16; ++i) { const size_t ix = (size_t)t * DM + lane + 64 * i; v[i] = ALPHA * bf2f(x1b[ix]) + bf2f(ys0[ix]) + bf2f(ys1[ix]); s += v[i]; }
    const float mean = wave_sum(s) * (1.0f / DM);
    float q = 0.f;
#pragma unroll
    for (int i = 0; i < 16; ++i) { v[i] -= mean; q += v[i] * v[i]; }
    const float rstd = rsqrtf(wave_sum(q) * (1.0f / DM) + LN_EPS);
#pragma unroll
    for (int i = 0; i < 16; ++i) { const int c = lane + 64 * i; const float y = v[i] * rstd * g[c] + bta[c]; const size_t ix = (size_t)t * DM + c;
        if (xb_out) xb_out[ix] = f2bf(y); if (fout) fout[ix] = y; }
}


#define LAS __attribute__((address_space(3)))
#define GAS __attribute__((address_space(1)))
typedef short bf16x8 __attribute__((ext_vector_type(8)));
typedef float f32x4 __attribute__((ext_vector_type(4)));
typedef float f32x2 __attribute__((ext_vector_type(2)));
typedef float f32x16 __attribute__((ext_vector_type(16)));
typedef unsigned u32x4 __attribute__((ext_vector_type(4)));
typedef unsigned u32x2 __attribute__((ext_vector_type(2)));
constexpr int NWAVES = 8, NTHREADS = 512;
constexpr int LDS_BYTES = 147456;
constexpr int RING_BYTES = 131072;
constexpr int MISC_OFF = RING_BYTES;

constexpr size_t WT_IN0 = WS_WT;
constexpr size_t WT_OUT0 = WT_IN0 + (size_t)2560 * 1024 * 2;
constexpr size_t WT_GU0 = WT_OUT0 + (size_t)1024 * 1024 * 2;
constexpr size_t WT_D0 = WT_GU0 + (size_t)16 * 1024 * 1024 * 2;
constexpr size_t WT_IN1 = WT_D0 + (size_t)16 * 1024 * 512 * 2;
constexpr size_t WT_OUT1 = WT_IN1 + (size_t)2048 * 1024 * 2;
constexpr size_t WT_GU1 = WT_OUT1 + (size_t)1024 * 1024 * 2;
constexpr size_t WT_D1 = WT_GU1 + (size_t)16 * 1024 * 1024 * 2;
constexpr size_t WT_END = WT_D1 + (size_t)16 * 1024 * 512 * 2;
static_assert(WT_END <= WS_XB, "weight copies overflow their region");

__device__ __forceinline__ unsigned cvt_pk_bf16(float lo, float hi) { unsigned r; asm volatile("v_cvt_pk_bf16_f32 %0, %1, %2" : "=v"(r) : "v"(lo), "v"(hi)); return r; }
#define LDS_WAIT() asm volatile("s_waitcnt lgkmcnt(0)" ::: "memory")
#define VM_WAIT() asm volatile("s_waitcnt vmcnt(0)" ::: "memory")

struct Args {
    const float* in[32]; float* out; unsigned char* ws; int ph_lo, ph_hi;
};

namespace pg8 {
constexpr int BM = 256, BK = 64, HALF = 128, HTB = HALF * BK * 2, STAGE_BYTES = 8 * HTB;
static_assert(STAGE_BYTES <= RING_BYTES, "stage buffers");
__host__ __device__ __forceinline__ int lds_byte(int r, int c) { const int st = (r >> 4) * 2 + (c >> 5), rr = r & 15, cc = c & 31, ob = rr * 64 + cc * 2; return st * 1024 + (ob ^ (((ob >> 9) & 1) << 5)); }
__host__ __device__ __forceinline__ void stage_rc(int b, int& R, int& C) { const int st = b / 1024, sb = b % 1024, swz = sb ^ (((sb >> 9) & 1) << 5); R = (st >> 1) * 16 + swz / 64; C = (st & 1) * 32 + (swz % 64) / 2; }
__host__ __device__ __forceinline__ int perm32(int rho) { const int n = rho >> 4, i = rho & 15; return 8 * (i >> 2) + 4 * n + (i & 3); }

struct Unit { int pm, pn, e, cnt, rb; };

template <class Epi, class Sched, bool GATHER, bool ALIGN_EPI>
__device__ __forceinline__ void gemm_phase(LAS unsigned char* lds, const int K, const Sched& S, const Epi& E) {
    const int tid = threadIdx.x, wid = __builtin_amdgcn_readfirstlane(tid >> 6), lane = tid & 63, wr = wid >> 2, wc = wid & 3, fr = lane & 15, fq = lane >> 4;
    const int nt = K / BK;
    unsigned voffB[2], coff0[2], coff1[2], noff0[2], noff1[2]; int RA[2], CA2[2];
#pragma unroll
    for (int i = 0; i < 2; ++i) { int R, C; stage_rc(tid * 16 + i * 8192, R, C); const int Rb = Epi::PERM ? ((R & ~31) + perm32(R & 31)) : R;
        voffB[i] = (unsigned)(Rb * K + C) * 2u; RA[i] = R; CA2[i] = C * 2;
        coff0[i] = (unsigned)(R * K + C) * 2u; coff1[i] = coff0[i] + (unsigned)(HALF * K * 2); noff0[i] = coff0[i]; noff1[i] = coff1[i]; }
    const size_t kstep = (size_t)(BK * 2);
    const size_t hstep = (size_t)HALF * K * 2;
    const unsigned ldsw = (unsigned)wid * 1024u;
    const int aoff = lds_byte(wr * 64 + fr, fq * 8), boff = lds_byte(wc * 32 + fr, fq * 8);
#define PG8_SA(b, h) (((b) * 2 + (h)) * HTB)
#define PG8_SB(b, h) ((4 + (b) * 2 + (h)) * HTB)
#define PG8_STAGE(bufoff, gbase, voff) do { _Pragma("unroll") for (int _i = 0; _i < 2; ++_i) \
        __builtin_amdgcn_global_load_lds((const unsigned*)((const char*)(gbase) + (voff)[_i]), (LAS unsigned*)(lds + (bufoff) + ldsw + _i * 8192), 16, 0, 0); } while (0)
#define PG8_LDA(dst, b, h) do { _Pragma("unroll") for (int m = 0; m < 4; ++m) _Pragma("unroll") for (int k = 0; k < 2; ++k) dst[m][k] = *(const LAS bf16x8*)(lds + PG8_SA(b, h) + aoff + m * 2048 + k * 1024); } while (0)
#define PG8_LDB(dst, b, h) do { _Pragma("unroll") for (int n = 0; n < 2; ++n) _Pragma("unroll") for (int k = 0; k < 2; ++k) dst[n][k] = *(const LAS bf16x8*)(lds + PG8_SB(b, h) + boff + n * 2048 + k * 1024); } while (0)
#define PG8_MMA(ai, bj, At, Bt) do { __builtin_amdgcn_s_setprio(1); _Pragma("unroll") for (int m = 0; m < 4; ++m) _Pragma("unroll") for (int n = 0; n < 2; ++n) _Pragma("unroll") for (int k = 0; k < 2; ++k) \
        acc[ai][bj][m][n] = __builtin_amdgcn_mfma_f32_16x16x32_bf16(Bt[n][k], At[m][k], acc[ai][bj][m][n], 0, 0, 0); __builtin_amdgcn_s_setprio(0); } while (0)
#define PG8_WAIT_V(n) asm volatile("s_waitcnt vmcnt(" #n ")" ::: "memory")
#define PG8_WAIT_L(n) asm volatile("s_waitcnt lgkmcnt(" #n ")" ::: "memory")
#define PG8_BAR __builtin_amdgcn_s_barrier()
#define PG8_SCHED __builtin_amdgcn_sched_barrier(0)
    Unit cur, nxt; int ui = 0;
    if (!S.next(0, cur)) return;
    if constexpr (GATHER) {
        asm volatile("" ::: "memory");
#pragma unroll
        for (int i = 0; i < 2; ++i) { coff0[i] = S.arow(cur, RA[i]) + (unsigned)CA2[i]; coff1[i] = S.arow(cur, HALF + RA[i]) + (unsigned)CA2[i]; }
        VM_WAIT();
        asm volatile("" : "+v"(coff0[0]), "+v"(coff0[1]), "+v"(coff1[0]), "+v"(coff1[1]));
    }
    f32x4 acc[2][2][4][2];
#pragma unroll
    for (int a = 0; a < 2; ++a)
#pragma unroll
        for (int b = 0; b < 2; ++b)
#pragma unroll
            for (int m = 0; m < 4; ++m)
#pragma unroll
                for (int n = 0; n < 2; ++n) acc[a][b][m][n] = (f32x4){0.f, 0.f, 0.f, 0.f};
    bf16x8 At[4][2], B0[2][2], B1[2][2];
    const char* cA = S.abase(cur); const char* cB = S.bbase(cur);
    PG8_STAGE(PG8_SB(0, 0), cB, voffB); PG8_STAGE(PG8_SB(0, 1), cB + hstep, voffB); PG8_STAGE(PG8_SA(0, 0), cA, coff0); PG8_STAGE(PG8_SA(0, 1), cA, coff1);
    if (wr == 1) PG8_BAR;
    PG8_WAIT_V(2); PG8_BAR;
    PG8_STAGE(PG8_SB(1, 0), cB + kstep, voffB); PG8_STAGE(PG8_SA(1, 0), cA + kstep, coff0); PG8_STAGE(PG8_SB(1, 1), cB + hstep + kstep, voffB);
    PG8_WAIT_V(6); PG8_BAR;
    for (;;) {
        const bool has_next = S.next(ui + 1, nxt);
        const char* nA = has_next ? S.abase(nxt) : cA; const char* nB = has_next ? S.bbase(nxt) : cB;
        if constexpr (GATHER) {
            if (has_next) {
                asm volatile("" ::: "memory");
#pragma unroll
                for (int i = 0; i < 2; ++i) { noff0[i] = S.arow(nxt, RA[i]) + (unsigned)CA2[i]; noff1[i] = S.arow(nxt, HALF + RA[i]) + (unsigned)CA2[i]; }
                VM_WAIT();
                asm volatile("" : "+v"(noff0[0]), "+v"(noff0[1]), "+v"(noff1[0]), "+v"(noff1[1]));
            } else {
#pragma unroll
                for (int i = 0; i < 2; ++i) { noff0[i] = coff0[i]; noff1[i] = coff1[i]; }
            }
        }
        for (int t = 0; t < nt; t += 2) {
            const bool last = (t == nt - 2);
            const char* a1 = cA + (size_t)(t + 1) * kstep;
            const char* a2 = last ? nA : cA + (size_t)(t + 2) * kstep; const char* b2 = last ? nB : cB + (size_t)(t + 2) * kstep;
            const char* a3 = a2 + kstep; const char* b3 = b2 + kstep;
            unsigned o20[2], o21[2];
#pragma unroll
            for (int i = 0; i < 2; ++i) { o20[i] = (GATHER && last) ? noff0[i] : coff0[i]; o21[i] = (GATHER && last) ? noff1[i] : coff1[i]; }
            PG8_LDB(B0, 0, 0); PG8_LDB(B1, 0, 1); PG8_SCHED; PG8_LDA(At, 0, 0); PG8_STAGE(PG8_SA(1, 1), a1, coff1);
            PG8_WAIT_V(8); PG8_WAIT_L(0); PG8_BAR; PG8_MMA(0, 0, At, B0); PG8_MMA(0, 1, At, B1); PG8_BAR; PG8_SCHED;
            PG8_LDA(At, 0, 1); PG8_STAGE(PG8_SB(0, 0), b2, voffB); PG8_STAGE(PG8_SB(0, 1), b2 + hstep, voffB); PG8_STAGE(PG8_SA(0, 0), a2, o20);
            PG8_WAIT_V(8); PG8_WAIT_L(0); PG8_BAR; PG8_MMA(1, 0, At, B0); PG8_MMA(1, 1, At, B1); PG8_BAR; PG8_SCHED;
            PG8_LDB(B0, 1, 0); PG8_LDB(B1, 1, 1); PG8_SCHED; PG8_LDA(At, 1, 0); PG8_STAGE(PG8_SA(0, 1), a2, o21);
            PG8_WAIT_V(8); PG8_WAIT_L(0); PG8_BAR; PG8_MMA(0, 0, At, B0); PG8_MMA(0, 1, At, B1); PG8_BAR; PG8_SCHED;
            PG8_LDA(At, 1, 1); PG8_STAGE(PG8_SB(1, 0), b3, voffB); PG8_STAGE(PG8_SB(1, 1), b3 + hstep, voffB); PG8_STAGE(PG8_SA(1, 0), a3, o20);
            PG8_WAIT_V(8); PG8_WAIT_L(0); PG8_BAR; PG8_MMA(1, 0, At, B0); PG8_MMA(1, 1, At, B1); PG8_BAR; PG8_SCHED;
        }
        if constexpr (ALIGN_EPI) { if (wr == 0) PG8_BAR; }
        E(acc, cur, wr, wc, fr, fq);
        if (!has_next) break;
#pragma unroll
        for (int a = 0; a < 2; ++a)
#pragma unroll
            for (int b = 0; b < 2; ++b)
#pragma unroll
                for (int m = 0; m < 4; ++m)
#pragma unroll
                    for (int n = 0; n < 2; ++n) acc[a][b][m][n] = (f32x4){0.f, 0.f, 0.f, 0.f};
        cur = nxt; cA = nA; cB = nB; ++ui;
        if constexpr (GATHER) {
#pragma unroll
            for (int i = 0; i < 2; ++i) { coff0[i] = noff0[i]; coff1[i] = noff1[i]; }
        }
        if constexpr (ALIGN_EPI) { if (wr == 1) PG8_BAR; }
    }
    PG8_WAIT_V(0);
    if constexpr (!ALIGN_EPI) { if (wr == 0) PG8_BAR; }
    PG8_BAR;
#undef PG8_SA
#undef PG8_SB
#undef PG8_STAGE
#undef PG8_LDA
#undef PG8_LDB
#undef PG8_MMA
#undef PG8_WAIT_V
#undef PG8_WAIT_L
#undef PG8_BAR
#undef PG8_SCHED
}

struct DenseSched {
    const bf16_t* A; const bf16_t* Bt; int K; int nM, nN, nwg, G, c;
    __device__ void init(const bf16_t* A_, const bf16_t* Bt_, int M, int N, int K_, int G_, int c_) { A = A_; Bt = Bt_; K = K_; nM = M / BM; nN = N / BM; nwg = nM * nN; G = G_; c = c_; }
    __device__ bool next(int i, Unit& u) const {
        const long L = (long)i * G + c; if (L >= nwg) return false;
        int wgid = (int)L; { const int q = nwg / 8, r = nwg % 8, xcd = wgid % 8, off = wgid / 8; wgid = (xcd < r ? xcd * (q + 1) : r * (q + 1) + (xcd - r) * q) + off; }
        const int WGM = 8; const int nig = WGM * nN, gid = wgid / nig, fm = gid * WGM, gsz = (nM - fm) < WGM ? (nM - fm) : WGM;
        u.pm = fm + ((wgid % nig) % gsz); u.pn = (wgid % nig) / gsz; u.e = 0; u.cnt = 1 << 30; u.rb = 0; return true;
    }
    __device__ const char* abase(const Unit& u) const { return (const char*)A + (size_t)u.pm * BM * K * 2; }
    __device__ const char* bbase(const Unit& u) const { return (const char*)Bt + (size_t)u.pn * BM * K * 2; }
    __device__ unsigned arow(const Unit&, int) const { return 0u; }
};

__device__ __forceinline__ void st_bf16x4(bf16_t* p, f32x4 v) { u32x2 w; w.x = cvt_pk_bf16(v[0], v[1]); w.y = cvt_pk_bf16(v[2], v[3]); *(u32x2*)p = w; }

struct EpiIn0F {
    static constexpr bool PERM = false;
    bf16_t* pbuf; const float2* cs;
    __device__ __forceinline__ void operator()(const f32x4 (&acc)[2][2][4][2], const Unit& u, int wr, int wc, int fr, int fq) const {
        const int kind = (u.pn < 4) ? 0 : (u.pn < 6) ? 1 : (u.pn < 8) ? 2 : 3;
#pragma unroll
        for (int ai = 0; ai < 2; ++ai)
#pragma unroll
            for (int m = 0; m < 4; ++m) {
                const int row = u.pm * BM + ai * HALF + wr * 64 + m * 16 + fr;
#pragma unroll
                for (int bj = 0; bj < 2; ++bj) {
                    const f32x4 v0 = acc[ai][bj][m][0], v1 = acc[ai][bj][m][1];
                    const int gl = 4 * bj + wc;
                    if (kind == 0) {
                        f32x4 o;
#pragma unroll
                        for (int q = 0; q < 4; ++q) o[q] = v0[q] * sigmoidf_(v1[q]);
                        st_bf16x4(pbuf + (size_t)row * 512 + 16 * (8 * u.pn + gl) + 4 * fq, o);
                    } else if (kind == 3) {
                        bf16_t* vb = pbuf + (size_t)3 * T_TOK * 512 + (size_t)row * 512 + 256 * (u.pn - 8) + 128 * bj + 32 * wc + 4 * fq;
                        st_bf16x4(vb, v0); st_bf16x4(vb + 16, v1);
                    } else {
                        const int G = 8 * (u.pn - (kind == 1 ? 4 : 6)) + gl, unit64 = G >> 1, dlo = 16 * (G & 1) + 4 * fq, pos = row & (SEQ - 1);
                        const f32x4 c01 = *(const f32x4*)(cs + pos * 32 + dlo), c23 = *(const f32x4*)(cs + pos * 32 + dlo + 2);
                        const float co[4] = {c01[0], c01[2], c23[0], c23[2]}, si[4] = {c01[1], c01[3], c23[1], c23[3]};
                        f32x4 lo, hi; const float sc = (kind == 1) ? QSCALE : 1.0f;
#pragma unroll
                        for (int q = 0; q < 4; ++q) { lo[q] = (v0[q] * co[q] - v1[q] * si[q]) * sc; hi[q] = (v1[q] * co[q] + v0[q] * si[q]) * sc; }
                        bf16_t* ob = pbuf + (size_t)kind * T_TOK * 512 + (size_t)row * 512 + 64 * unit64 + dlo;
                        st_bf16x4(ob, lo); st_bf16x4(ob + 32, hi);
                    }
                }
            }
    }
};
struct EpiPlainF {
    static constexpr bool PERM = true;
    bf16_t* O; int ldc; int scale_cols; float scale;
    __device__ __forceinline__ void operator()(const f32x4 (&acc)[2][2][4][2], const Unit& u, int wr, int wc, int fr, int fq) const {
        const float sc = (u.pn * BM < scale_cols) ? scale : 1.0f;
#pragma unroll
        for (int ai = 0; ai < 2; ++ai)
#pragma unroll
            for (int m = 0; m < 4; ++m) { bf16_t* rowp = O + (size_t)(u.pm * BM + ai * HALF + wr * 64 + m * 16 + fr) * ldc + u.pn * BM + wc * 32 + 8 * fq;
#pragma unroll
                for (int bj = 0; bj < 2; ++bj) { const f32x4 v0 = acc[ai][bj][m][0] * sc, v1 = acc[ai][bj][m][1] * sc;
                    u32x4 w; w.x = cvt_pk_bf16(v0[0], v0[1]); w.y = cvt_pk_bf16(v0[2], v0[3]); w.z = cvt_pk_bf16(v1[0], v1[1]); w.w = cvt_pk_bf16(v1[2], v1[3]);
                    *(u32x4*)(rowp + bj * HALF) = w; } }
    }
};
struct EpiResF {
    static constexpr bool PERM = true;
    bf16_t* Y; const bf16_t* X;
    __device__ __forceinline__ void operator()(const f32x4 (&acc)[2][2][4][2], const Unit& u, int wr, int wc, int fr, int fq) const {
#pragma unroll
        for (int ai = 0; ai < 2; ++ai)
#pragma unroll
            for (int m = 0; m < 4; ++m) { const size_t off = (size_t)(u.pm * BM + ai * HALF + wr * 64 + m * 16 + fr) * DM + u.pn * BM + wc * 32 + 8 * fq;
#pragma unroll
                for (int bj = 0; bj < 2; ++bj) { const f32x4 v0 = acc[ai][bj][m][0], v1 = acc[ai][bj][m][1];
                    const u32x4 xr = *(const u32x4*)(X + off + bj * HALF);
                    float r[8];
#pragma unroll
                    for (int q = 0; q < 4; ++q) { r[2 * q] = __uint_as_float(xr[q] << 16); r[2 * q + 1] = __uint_as_float(xr[q] & 0xffff0000u); }
                    u32x4 w; w.x = cvt_pk_bf16(ALPHA * r[0] + v0[0], ALPHA * r[1] + v0[1]); w.y = cvt_pk_bf16(ALPHA * r[2] + v0[2], ALPHA * r[3] + v0[3]);
                    w.z = cvt_pk_bf16(ALPHA * r[4] + v1[0], ALPHA * r[5] + v1[1]); w.w = cvt_pk_bf16(ALPHA * r[6] + v1[2], ALPHA * r[7] + v1[3]);
                    *(u32x4*)(Y + off + bj * HALF) = w; } }
    }
};

struct MoeSched {
    const bf16_t* A; const bf16_t* Bt; const int* ltok; const LAS int* tab; int K, nN, G, c; bool gather;
    __device__ bool next(int i, Unit& u) const {
        const int L = i * G + c; if (L >= tab[32] * nN) return false;
        const int mt = L / nN; int e = 0;
#pragma unroll
        for (int j = 1; j < 16; ++j) e += (tab[16 + j] <= mt) ? 1 : 0;
        u.e = e; u.pm = mt - tab[16 + e]; u.pn = L - mt * nN; u.cnt = tab[e]; u.rb = tab[33 + e]; return true;
    }
    __device__ const char* abase(const Unit& u) const { return gather ? (const char*)A : (const char*)A + (size_t)(u.rb + u.pm * BM) * K * 2; }
    __device__ const char* bbase(const Unit& u) const { return (const char*)Bt + ((size_t)u.e * 1024 + (size_t)u.pn * BM) * K * 2; }
    __device__ unsigned arow(const Unit& u, int R) const { int slot = u.pm * BM + R; slot = slot < u.cnt ? slot : u.cnt - 1; const int tk = ltok[u.e * T_TOK + slot]; return (unsigned)(tk >> 1) * (unsigned)(K * 2); }
};
struct EpiGUF {
    static constexpr bool PERM = false;
    bf16_t* H; const float* lgate;
    __device__ __forceinline__ void operator()(const f32x4 (&acc)[2][2][4][2], const Unit& u, int wr, int wc, int fr, int fq) const {
#pragma unroll
        for (int ai = 0; ai < 2; ++ai)
#pragma unroll
            for (int m = 0; m < 4; ++m) {
                const int slot = u.pm * BM + ai * HALF + wr * 64 + m * 16 + fr;
                if (slot < u.cnt) {
                    const float gt = lgate[u.e * T_TOK + slot];
                    bf16_t* hp = H + (size_t)(u.rb + slot) * DFF + 16 * (8 * u.pn + wc) + 4 * fq;
#pragma unroll
                    for (int bj = 0; bj < 2; ++bj) { const f32x4 v0 = acc[ai][bj][m][0], v1 = acc[ai][bj][m][1]; f32x4 o;
#pragma unroll
                        for (int q = 0; q < 4; ++q) o[q] = v0[q] * sigmoidf_(v0[q]) * v1[q] * gt;
                        st_bf16x4(hp + 64 * bj, o); }
                }
            }
    }
};
struct EpiDownF {
    static constexpr bool PERM = true;
    bf16_t* ys0; long ysd; const int* ltok;
    __device__ __forceinline__ void operator()(const f32x4 (&acc)[2][2][4][2], const Unit& u, int wr, int wc, int fr, int fq) const {
#pragma unroll
        for (int ai = 0; ai < 2; ++ai)
#pragma unroll
            for (int m = 0; m < 4; ++m) {
                const int slot = u.pm * BM + ai * HALF + wr * 64 + m * 16 + fr;
                if (slot < u.cnt) {
                    const int tk = ltok[u.e * T_TOK + slot];
                    bf16_t* rowp = ys0 + (long)(tk & 1) * ysd + (long)(tk >> 1) * DM + u.pn * BM + wc * 32 + 8 * fq;
#pragma unroll
                    for (int bj = 0; bj < 2; ++bj) { const f32x4 v0 = acc[ai][bj][m][0], v1 = acc[ai][bj][m][1];
                        u32x4 w; w.x = cvt_pk_bf16(v0[0], v0[1]); w.y = cvt_pk_bf16(v0[2], v0[3]); w.z = cvt_pk_bf16(v1[0], v1[1]); w.w = cvt_pk_bf16(v1[2], v1[3]);
                        *(u32x4*)(rowp + bj * HALF) = w; }
                }
            }
    }
};
}

template <class L>
__device__ __forceinline__ void transpose_item(const L& ld, int K, bf16_t* WT, int nblk, LAS float* scr, int item, int lane) {
    const int kb = item / nblk, nb = item % nblk, k0 = 64 * kb, n0 = 32 * nb;
#pragma unroll 8
    for (int i = 0; i < 32; ++i) { const int kk = 2 * i + (lane >> 5); scr[kk * 33 + (lane & 31)] = ld(k0 + kk, n0 + (lane & 31)); }
    LDS_WAIT(); asm volatile("" ::: "memory");
    const int c = lane & 7;
#pragma unroll
    for (int j = 0; j < 4; ++j) { const int n = (lane >> 3) + 8 * j; const LAS float* s = scr + (8 * c) * 33 + n;
        u32x4 o; o.x = cvt_pk_bf16(s[0 * 33], s[1 * 33]); o.y = cvt_pk_bf16(s[2 * 33], s[3 * 33]); o.z = cvt_pk_bf16(s[4 * 33], s[5 * 33]); o.w = cvt_pk_bf16(s[6 * 33], s[7 * 33]);
        *(u32x4*)(WT + (size_t)(n0 + n) * K + k0 + 8 * c) = o; }
    LDS_WAIT(); asm volatile("" ::: "memory");
}
struct LdPlain { const float* W; int ldw; __device__ __forceinline__ float operator()(int k, int n) const { return W[(size_t)k * ldw + n]; } };
struct LdIn0 {
    const float* W;
    __device__ __forceinline__ float operator()(int k, int n) const {
        int col;
        if (n < 1024) { const int G = n >> 5, nn = (n >> 4) & 1, i = n & 15; col = nn * 512 + 16 * G + i; }
        else if (n < 2048) { const int base = (n < 1536) ? 1024 : 1536, p = n - base, G = p >> 5, nn = (p >> 4) & 1, i = p & 15; col = base + 64 * (G >> 1) + 16 * (G & 1) + i + 32 * nn; }
        else col = n;
        return W[(size_t)k * 2560 + col];
    }
};
struct LdGU {
    const float* Wg; const float* Wu;
    __device__ __forceinline__ float operator()(int k, int n) const { const int G = n >> 5, nn = (n >> 4) & 1, i = n & 15;
        const uintptr_t d = (uintptr_t)Wu - (uintptr_t)Wg; const float* p = (const float*)((uintptr_t)Wg + (nn ? d : (uintptr_t)0)); return p[(size_t)k * DFF + 16 * G + i]; }
};
struct LdFold {
    const float* op; const float* pw; const float* ps;
    __device__ __forceinline__ float operator()(int k, int n) const {
        if (k < 512) return op[(size_t)k * DM + n];
        const int g = (k - 512) >> 7, c = (k - 512) & 127; float a = 0.f;
        for (int d = 0; d < 128; ++d) a += pw[(g * 128 + c) * 128 + d] * ps[g * 128 + d] * op[(size_t)(512 + g * 128 + d) * DM + n];
        return a;
    }
};

struct Frame { LAS unsigned char* lds; int tid, lane, wave, G, vcu; };

__device__ __forceinline__ void p0_prologue(const Frame& F, const Args& a) {
    LAS float* scr = (LAS float*)(F.lds + F.wave * 16384);
    const int gw = F.vcu * NWAVES + F.wave, NGW = F.G * NWAVES;
    unsigned char* ws = a.ws;
    constexpr int I_IN0 = 16 * 80, I_OUT = 16 * 32, I_GU = 16 * 32, I_D = 8 * 32, I_IN1 = 16 * 64;
    constexpr int S0 = I_IN0, S1 = S0 + I_OUT, S2 = S1 + 16 * I_GU, S3 = S2 + 16 * I_D, S4 = S3 + I_IN1, S5 = S4 + I_OUT, S6 = S5 + 16 * I_GU, S7 = S6 + 16 * I_D;
    for (int it = gw; it < S7; it += NGW) {
        if (it < S0) { LdIn0 l{a.in[3]}; transpose_item(l, 1024, (bf16_t*)(ws + WT_IN0), 80, scr, it, F.lane); }
        else if (it < S1) { LdPlain l{a.in[13], 1024}; transpose_item(l, 1024, (bf16_t*)(ws + WT_OUT0), 32, scr, it - S0, F.lane); }
        else if (it < S2) { const int r = it - S1, e = r / I_GU; LdGU l{a.in[16] + (size_t)e * DM * DFF, a.in[17] + (size_t)e * DM * DFF}; transpose_item(l, 1024, (bf16_t*)(ws + WT_GU0) + (size_t)e * 1024 * 1024, 32, scr, r % I_GU, F.lane); }
        else if (it < S3) { const int r = it - S2, e = r / I_D; LdPlain l{a.in[18] + (size_t)e * DFF * DM, 1024}; transpose_item(l, 512, (bf16_t*)(ws + WT_D0) + (size_t)e * 1024 * 512, 32, scr, r % I_D, F.lane); }
        else if (it < S4) { LdPlain l{a.in[21], 2048}; transpose_item(l, 1024, (bf16_t*)(ws + WT_IN1), 64, scr, it - S3, F.lane); }
        else if (it < S5) { LdFold l{a.in[24], a.in[22], a.in[23]}; transpose_item(l, 1024, (bf16_t*)(ws + WT_OUT1), 32, scr, it - S4, F.lane); }
        else if (it < S6) { const int r = it - S5, e = r / I_GU; LdGU l{a.in[27] + (size_t)e * DM * DFF, a.in[28] + (size_t)e * DM * DFF}; transpose_item(l, 1024, (bf16_t*)(ws + WT_GU1) + (size_t)e * 1024 * 1024, 32, scr, r % I_GU, F.lane); }
        else { const int r = it - S6, e = r / I_D; LdPlain l{a.in[29] + (size_t)e * DFF * DM, 1024}; transpose_item(l, 512, (bf16_t*)(ws + WT_D1) + (size_t)e * 1024 * 512, 32, scr, r % I_D, F.lane); }
    }
    { const float* x = a.in[0]; bf16_t* xb = (bf16_t*)(ws + WS_XB); const size_t n8 = (size_t)T_TOK * DM / 8, stride = (size_t)F.G * NTHREADS;
      for (size_t i = (size_t)F.vcu * NTHREADS + F.tid; i < n8; i += stride) { const f32x4 v0 = *(const f32x4*)(x + i * 8), v1 = *(const f32x4*)(x + i * 8 + 4);
          u32x4 w; w.x = cvt_pk_bf16(v0[0], v0[1]); w.y = cvt_pk_bf16(v0[2], v0[3]); w.z = cvt_pk_bf16(v1[0], v1[1]); w.w = cvt_pk_bf16(v1[2], v1[3]); *(u32x4*)(xb + i * 8) = w; } }
    { float2* cs = (float2*)(ws + WS_ROPE);
      for (int i = F.vcu * NTHREADS + F.tid; i < SEQ * 32; i += F.G * NTHREADS) { const int pos = i >> 5, f = i & 31; const float inv = powf(10000.0f, -(float)(2 * f) / 64.0f); float s, c; sincosf((float)pos * inv, &s, &c); cs[i] = make_float2(c, s); } }
}


__device__ __forceinline__ float bflo(unsigned w) { return __uint_as_float(w << 16); }
__device__ __forceinline__ float bfhi(unsigned w) { return __uint_as_float(w & 0xffff0000u); }

__device__ __forceinline__ void ph_ln_router(const Frame& F, const bf16_t* Y, const float* g, const float* bta, const float* rw, const float* rb,
                                             bf16_t* x1b, int* ltok, float* lgate, int* cnt) {
    LAS float* rwT = (LAS float*)F.lds;
    LAS float* lgs = (LAS float*)(F.lds + 65536) + F.wave * 16;
    for (int i = F.tid; i < 16 * 1024; i += NTHREADS) { const int c = i >> 4, e = i & 15; rwT[e * 1024 + c] = rw[i]; }
    __syncthreads();
    const int lane = F.lane, gw = F.vcu * NWAVES + F.wave, NGW = F.G * NWAVES;
    float gam[16], bet[16];
#pragma unroll
    for (int j = 0; j < 4; ++j) { const f32x4 a = *(const f32x4*)(g + 4 * lane + 256 * j), b = *(const f32x4*)(bta + 4 * lane + 256 * j);
#pragma unroll
        for (int q = 0; q < 4; ++q) { gam[4 * j + q] = a[q]; bet[4 * j + q] = b[q]; } }
    for (int t = gw; t < T_TOK; t += NGW) {
        float v[16], s = 0.f;
#pragma unroll
        for (int j = 0; j < 4; ++j) { const u32x2 w = *(const u32x2*)(Y + (size_t)t * DM + 4 * lane + 256 * j);
            v[4 * j] = bflo(w.x); v[4 * j + 1] = bfhi(w.x); v[4 * j + 2] = bflo(w.y); v[4 * j + 3] = bfhi(w.y); }
#pragma unroll
        for (int i = 0; i < 16; ++i) s += v[i];
        const float mean = wave_sum(s) * (1.0f / DM);
        float q2 = 0.f;
#pragma unroll
        for (int i = 0; i < 16; ++i) { v[i] -= mean; q2 += v[i] * v[i]; }
        const float rstd = rsqrtf(wave_sum(q2) * (1.0f / DM) + LN_EPS);
#pragma unroll
        for (int i = 0; i < 16; ++i) v[i] = v[i] * rstd * gam[i] + bet[i];
#pragma unroll
        for (int j = 0; j < 4; ++j) { u32x2 w; w.x = cvt_pk_bf16(v[4 * j], v[4 * j + 1]); w.y = cvt_pk_bf16(v[4 * j + 2], v[4 * j + 3]); *(u32x2*)(x1b + (size_t)t * DM + 4 * lane + 256 * j) = w; }
        float lg[16];
#pragma unroll
        for (int e = 0; e < 16; ++e) { float a = 0.f;
#pragma unroll
            for (int j = 0; j < 4; ++j) { const f32x4 w = *(const LAS f32x4*)(rwT + e * 1024 + 4 * lane + 256 * j);
                a += v[4 * j] * w[0] + v[4 * j + 1] * w[1] + v[4 * j + 2] * w[2] + v[4 * j + 3] * w[3]; }
            lg[e] = a; }
        float r8[8], r4[4], r2[2], r1;
        { const bool up = (lane & 32) != 0;
#pragma unroll
          for (int i = 0; i < 8; ++i) { const float send = up ? lg[i] : lg[i + 8]; const float keep = up ? lg[i + 8] : lg[i]; r8[i] = keep + __shfl_xor(send, 32); } }
        { const bool up = (lane & 16) != 0;
#pragma unroll
          for (int i = 0; i < 4; ++i) { const float send = up ? r8[i] : r8[i + 4]; const float keep = up ? r8[i + 4] : r8[i]; r4[i] = keep + __shfl_xor(send, 16); } }
        { const bool up = (lane & 8) != 0;
#pragma unroll
          for (int i = 0; i < 2; ++i) { const float send = up ? r4[i] : r4[i + 2]; const float keep = up ? r4[i + 2] : r4[i]; r2[i] = keep + __shfl_xor(send, 8); } }
        { const bool up = (lane & 4) != 0; const float send = up ? r2[0] : r2[1]; const float keep = up ? r2[1] : r2[0]; r1 = keep + __shfl_xor(send, 4); }
        r1 += __shfl_xor(r1, 1); r1 += __shfl_xor(r1, 2);
        if ((lane & 3) == 0) lgs[((lane >> 5) & 1) * 8 + ((lane >> 4) & 1) * 4 + ((lane >> 3) & 1) * 2 + ((lane >> 2) & 1)] = r1;
        LDS_WAIT(); asm volatile("" ::: "memory");
        if (lane == 0) {
            float aff[16], sel[16];
#pragma unroll
            for (int e = 0; e < 16; ++e) { aff[e] = 1.0f / (1.0f + expf(-lgs[e])); sel[e] = aff[e] + rb[e]; }
            int gb = 0, bi1 = 0, bi2 = 1; float best = -INFINITY;
#pragma unroll
            for (int gi = 0; gi < 4; ++gi) {
                int i1 = 0; float v1 = sel[gi * 4];
#pragma unroll
                for (int k = 1; k < 4; ++k) if (sel[gi * 4 + k] > v1) { v1 = sel[gi * 4 + k]; i1 = k; }
                int i2 = -1; float v2 = -INFINITY;
#pragma unroll
                for (int k = 0; k < 4; ++k) if (k != i1 && sel[gi * 4 + k] > v2) { v2 = sel[gi * 4 + k]; i2 = k; }
                const float sc = v1 + v2;
                if (sc > best) { best = sc; gb = gi; bi1 = i1; bi2 = i2; }
            }
            const int e0 = gb * 4 + bi1, e1 = gb * 4 + bi2;
            float a0 = 0.f, a1 = 0.f;
#pragma unroll
            for (int e = 0; e < 16; ++e) { if (e == e0) a0 = aff[e]; if (e == e1) a1 = aff[e]; }
            const float g0 = a0 / (a0 + a1), g1 = a1 / (a0 + a1);
            const int s0 = atomicAdd(&cnt[e0], 1); ltok[e0 * T_TOK + s0] = t * 2 + 0; lgate[e0 * T_TOK + s0] = g0;
            const int s1 = atomicAdd(&cnt[e1], 1); ltok[e1 * T_TOK + s1] = t * 2 + 1; lgate[e1 * T_TOK + s1] = g1;
        }
        asm volatile("" ::: "memory");
    }
    __syncthreads();
}

__device__ __forceinline__ void ph_ln_ffn(const Frame& F, const bf16_t* x1b, const bf16_t* ys0, const bf16_t* ys1, const float* g, const float* bta, bf16_t* xb_out, float* fout) {
    const int lane = F.lane, gw = F.vcu * NWAVES + F.wave, NGW = F.G * NWAVES;
    float gam[16], bet[16];
#pragma unroll
    for (int j = 0; j < 4; ++j) { const f32x4 a = *(const f32x4*)(g + 4 * lane + 256 * j), b = *(const f32x4*)(bta + 4 * lane + 256 * j);
#pragma unroll
        for (int q = 0; q < 4; ++q) { gam[4 * j + q] = a[q]; bet[4 * j + q] = b[q]; } }
    for (int t = gw; t < T_TOK; t += NGW) {
        float v[16], s = 0.f;
#pragma unroll
        for (int j = 0; j < 4; ++j) { const size_t ix = (size_t)t * DM + 4 * lane + 256 * j;
            const u32x2 a = *(const u32x2*)(x1b + ix), b = *(const u32x2*)(ys0 + ix), c = *(const u32x2*)(ys1 + ix);
            v[4 * j] = ALPHA * bflo(a.x) + bflo(b.x) + bflo(c.x); v[4 * j + 1] = ALPHA * bfhi(a.x) + bfhi(b.x) + bfhi(c.x);
            v[4 * j + 2] = ALPHA * bflo(a.y) + bflo(b.y) + bflo(c.y); v[4 * j + 3] = ALPHA * bfhi(a.y) + bfhi(b.y) + bfhi(c.y); }
#pragma unroll
        for (int i = 0; i < 16; ++i) s += v[i];
        const float mean = wave_sum(s) * (1.0f / DM);
        float q2 = 0.f;
#pragma unroll
        for (int i = 0; i < 16; ++i) { v[i] -= mean; q2 += v[i] * v[i]; }
        const float rstd = rsqrtf(wave_sum(q2) * (1.0f / DM) + LN_EPS);
#pragma unroll
        for (int i = 0; i < 16; ++i) v[i] = v[i] * rstd * gam[i] + bet[i];
#pragma unroll
        for (int j = 0; j < 4; ++j) { const size_t ix = (size_t)t * DM + 4 * lane + 256 * j;
            if (xb_out) { u32x2 w; w.x = cvt_pk_bf16(v[4 * j], v[4 * j + 1]); w.y = cvt_pk_bf16(v[4 * j + 2], v[4 * j + 3]); *(u32x2*)(xb_out + ix) = w; }
            if (fout) *(f32x4*)(fout + ix) = (f32x4){v[4 * j], v[4 * j + 1], v[4 * j + 2], v[4 * j + 3]}; }
    }
}

__device__ __forceinline__ void conv_unit(const Frame& F, int unit, const bf16_t* aglu, const float* cw, const float* cb, const float* g, const float* bta, bf16_t* mix) {
    LAS float* cv = (LAS float*)F.lds;
    const int t0 = unit * 32, cp = F.tid & 255, th = F.tid >> 8, c0 = 2 * cp;
    const int tb = t0 + th * 16, posb = tb & (SEQ - 1);
    float w0[31], w1[31];
#pragma unroll
    for (int w = 0; w < 31; ++w) { const f32x2 x = *(const f32x2*)(cw + w * 512 + c0); w0[w] = x[0]; w1[w] = x[1]; }
    const f32x2 bias = *(const f32x2*)(cb + c0);
    unsigned in[46];
#pragma unroll
    for (int r = 0; r < 46; ++r) { const int p = posb - 30 + r; in[r] = (p >= 0) ? *(const unsigned*)(aglu + (size_t)(tb - 30 + r) * 512 + c0) : 0u; }
    __syncthreads();
#pragma unroll
    for (int t = 0; t < 16; ++t) { float a0 = bias[0], a1 = bias[1];
#pragma unroll
        for (int w = 0; w < 31; ++w) { a0 += bflo(in[t + w]) * w0[w]; a1 += bfhi(in[t + w]) * w1[w]; }
        *(LAS f32x2*)(cv + (th * 16 + t) * 512 + c0) = (f32x2){a0, a1}; }
    __syncthreads();
    const int lane = F.lane;
    const f32x4 g0 = *(const f32x4*)(g + 8 * lane), g1 = *(const f32x4*)(g + 8 * lane + 4), b0 = *(const f32x4*)(bta + 8 * lane), b1 = *(const f32x4*)(bta + 8 * lane + 4);
#pragma unroll
    for (int k = 0; k < 4; ++k) { const int tl = F.wave * 4 + k;
        const f32x4 x0 = *(const LAS f32x4*)(cv + tl * 512 + 8 * lane), x1 = *(const LAS f32x4*)(cv + tl * 512 + 8 * lane + 4);
        float v[8] = {x0[0], x0[1], x0[2], x0[3], x1[0], x1[1], x1[2], x1[3]}, s = 0.f;
#pragma unroll
        for (int i = 0; i < 8; ++i) s += v[i];
        const float mean = wave_sum(s) * (1.0f / 512.0f); float q2 = 0.f;
#pragma unroll
        for (int i = 0; i < 8; ++i) { v[i] -= mean; q2 += v[i] * v[i]; }
        const float rstd = rsqrtf(wave_sum(q2) * (1.0f / 512.0f) + LN_EPS);
        const float gg[8] = {g0[0], g0[1], g0[2], g0[3], g1[0], g1[1], g1[2], g1[3]}, bb[8] = {b0[0], b0[1], b0[2], b0[3], b1[0], b1[1], b1[2], b1[3]};
#pragma unroll
        for (int i = 0; i < 8; ++i) { const float y = v[i] * rstd * gg[i] + bb[i]; v[i] = y * sigmoidf_(y); }
        u32x4 w; w.x = cvt_pk_bf16(v[0], v[1]); w.y = cvt_pk_bf16(v[2], v[3]); w.z = cvt_pk_bf16(v[4], v[5]); w.w = cvt_pk_bf16(v[6], v[7]);
        *(u32x4*)(mix + (size_t)(t0 + tl) * DM + 8 * lane) = w; }
}

__device__ __forceinline__ void pool_unit(const Frame& F, int unit, const bf16_t* P1, bf16_t* mix) {
    const int cp = F.tid & 255, th = F.tid >> 8, c0 = 2 * cp, grp = cp >> 6, win = 2 << grp;
    const int tb = unit * 64 + th * 32, posb = tb & (SEQ - 1);
    unsigned in[47];
#pragma unroll
    for (int r = 0; r < 47; ++r) { const int p = posb - 15 + r; in[r] = (p >= 0) ? *(const unsigned*)(P1 + (size_t)(tb - 15 + r) * 2048 + 1536 + c0) : 0u; }
#pragma unroll
    for (int t = 0; t < 32; ++t) { float s0 = 0.f, s1 = 0.f; const int pos = posb + t;
#pragma unroll
        for (int i = 0; i < 16; ++i) if (i < win) { s0 += bflo(in[15 + t - i]); s1 += bfhi(in[15 + t - i]); }
        const int cn = (pos + 1 < win) ? pos + 1 : win; const float ic = 1.0f / (float)cn;
        const float o0 = s0 * ic - bflo(in[15 + t]), o1 = s1 * ic - bfhi(in[15 + t]);
        *(unsigned*)(mix + (size_t)(tb + t) * DM + 512 + c0) = cvt_pk_bf16(o0, o1); }
}


namespace att {
typedef short v4i16 __attribute__((ext_vector_type(4)));
__device__ __forceinline__ int crow(int r, int hi) { return (r & 3) + 8 * (r >> 2) + 4 * hi; }
__device__ __forceinline__ v4i16 vtr(const LAS unsigned char* p) { return __builtin_amdgcn_ds_read_tr16_b64_v4i16((LAS v4i16*)p); }
__device__ __forceinline__ bf16x8 vfrag(const LAS unsigned char* p) { const v4i16 lo = vtr(p), hi = vtr(p + 512); return (bf16x8){lo[0], lo[1], lo[2], lo[3], hi[0], hi[1], hi[2], hi[3]}; }
__device__ __forceinline__ float ex2(float x) { return __builtin_amdgcn_exp2f(x); }
__device__ __forceinline__ float lg2(float x) { return __builtin_amdgcn_logf(x); }
__device__ __forceinline__ float partner32(float x, int hb) { auto rr = __builtin_amdgcn_permlane32_swap(__float_as_uint(x), __float_as_uint(x), false, false); return __uint_as_float(hb ? rr[0] : rr[1]); }
__device__ __forceinline__ bf16x8 pack8(const f32x16& p, int b) { u32x4 w; w.x = cvt_pk_bf16(p[b], p[b + 1]); w.y = cvt_pk_bf16(p[b + 2], p[b + 3]); w.z = cvt_pk_bf16(p[b + 4], p[b + 5]); w.w = cvt_pk_bf16(p[b + 6], p[b + 7]); return __builtin_bit_cast(bf16x8, w); }
#define GLDS16(src, dst) __builtin_amdgcn_global_load_lds((const unsigned*)(src), (LAS unsigned*)(dst), 16, 0, 0)

__device__ __forceinline__ void diff_unit(const Frame& F, int b, int h, int qblk, const bf16_t* Q, const bf16_t* K, const bf16_t* V, float lam, const float* sg, bf16_t* mix) {
    const int lane = F.lane, wid = F.wave, r32 = lane & 31, hb = lane >> 5, st = wid >> 2, ww = wid & 3;
    const size_t row0 = (size_t)b * SEQ;
    const int q0 = qblk * 128, qw0 = q0 + 32 * ww, qrow = qw0 + r32, nt = 2 * qblk + 2;
    bf16x8 qf[4];
    { const bf16_t* qp = Q + (row0 + qrow) * 512 + 128 * h + 64 * st + 8 * hb;
#pragma unroll
      for (int d0 = 0; d0 < 4; ++d0) qf[d0] = *(const bf16x8*)(qp + 16 * d0); }
    const bf16_t* src0; int dst0, sstep, dstep;
    if (wid < 4) { src0 = K + (row0 + lane) * 512 + 128 * h + 64 * (wid >> 1) + 32 * (wid & 1); sstep = 8; dst0 = (wid >> 1) * 8192 + (wid & 1) * 4096; dstep = 1024; }
    else { src0 = V + (row0 + 8 * (lane >> 5) + ((lane >> 2) & 7)) * 512 + 128 * h + 32 * (wid - 4) + 8 * (lane & 3); sstep = 16 * 512; dst0 = 16384 + (wid - 4) * 4096; dstep = 1024; }
#define DIFF_ISSUE(t, stg) do { const bf16_t* s_ = src0 + (size_t)(t) * 64 * 512; LAS unsigned char* d_ = F.lds + (stg) * 32768 + dst0; \
        _Pragma("unroll") for (int i_ = 0; i_ < 4; ++i_) GLDS16(s_ + (size_t)i_ * sstep, d_ + i_ * dstep); } while (0)
    f32x16 o[4];
#pragma unroll
    for (int d = 0; d < 4; ++d)
#pragma unroll
        for (int r = 0; r < 16; ++r) o[d][r] = 0.f;
    float m = -INFINITY, l = 0.f;
    const int vlane = (4 * hb + ((lane & 15) >> 2)) * 64 + ((lane >> 4) & 1) * 32 + (lane & 3) * 8;
    DIFF_ISSUE(0, 0);
    for (int t = 0; t < nt; ++t) {
        VM_WAIT(); __syncthreads();
        if (t + 1 < nt) DIFF_ISSUE(t + 1, (t + 1) & 1);
        const LAS unsigned char* sb = F.lds + (t & 1) * 32768;
        const int kv0 = 64 * t;
        if (kv0 <= qw0 + 31) {
            f32x16 p0, p1;
#pragma unroll
            for (int r = 0; r < 16; ++r) { p0[r] = 0.f; p1[r] = 0.f; }
            const LAS unsigned char* kb = sb + st * 8192 + hb * 1024 + r32 * 16;
#pragma unroll
            for (int d0 = 0; d0 < 4; ++d0) { const bf16x8 a0 = *(const LAS bf16x8*)(kb + d0 * 2048), a1 = *(const LAS bf16x8*)(kb + d0 * 2048 + 512);
                p0 = __builtin_amdgcn_mfma_f32_32x32x16_bf16(a0, qf[d0], p0, 0, 0, 0); p1 = __builtin_amdgcn_mfma_f32_32x32x16_bf16(a1, qf[d0], p1, 0, 0, 0); }
            if (kv0 + 63 > qw0) {
#pragma unroll
                for (int r = 0; r < 16; ++r) { const int kvg = kv0 + crow(r, hb); if (kvg > qrow) p0[r] = -INFINITY; if (kvg + 32 > qrow) p1[r] = -INFINITY; }
            }
            float mx = fmaxf(p0[0], p1[0]);
#pragma unroll
            for (int r = 1; r < 16; ++r) mx = fmaxf(mx, fmaxf(p0[r], p1[r]));
            mx = fmaxf(mx, partner32(mx, hb));
            const float mn = fmaxf(m, mx), alpha = ex2(m - mn); m = mn;
            float ls = 0.f;
#pragma unroll
            for (int r = 0; r < 16; ++r) { p0[r] = ex2(p0[r] - mn); p1[r] = ex2(p1[r] - mn); ls += p0[r] + p1[r]; }
            l = l * alpha + ls;
#pragma unroll
            for (int d = 0; d < 4; ++d)
#pragma unroll
                for (int r = 0; r < 16; ++r) o[d][r] *= alpha;
            const bf16x8 pf0 = pack8(p0, 0), pf1 = pack8(p0, 8), pf2 = pack8(p1, 0), pf3 = pack8(p1, 8);
            const LAS unsigned char* vb = sb + 16384 + vlane;
#pragma unroll
            for (int d = 0; d < 4; ++d) {
                o[d] = __builtin_amdgcn_mfma_f32_32x32x16_bf16(vfrag(vb + d * 4096), pf0, o[d], 0, 0, 0);
                o[d] = __builtin_amdgcn_mfma_f32_32x32x16_bf16(vfrag(vb + d * 4096 + 1024), pf1, o[d], 0, 0, 0);
                o[d] = __builtin_amdgcn_mfma_f32_32x32x16_bf16(vfrag(vb + d * 4096 + 2048), pf2, o[d], 0, 0, 0);
                o[d] = __builtin_amdgcn_mfma_f32_32x32x16_bf16(vfrag(vb + d * 4096 + 3072), pf3, o[d], 0, 0, 0);
            }
        }
    }
#undef DIFF_ISSUE
    { const float lt = l + partner32(l, hb), inv = 1.0f / lt;
#pragma unroll
      for (int d = 0; d < 4; ++d)
#pragma unroll
          for (int r = 0; r < 16; ++r) o[d][r] *= inv; }
    __syncthreads();
    LAS float* xb = (LAS float*)F.lds + ww * 4096;
    if (st == 1) {
#pragma unroll
        for (int d = 0; d < 4; ++d)
#pragma unroll
            for (int r = 0; r < 16; ++r) xb[(d * 16 + r) * 64 + lane] = o[d][r];
    }
    __syncthreads();
    if (st == 0) {
        float ss = 0.f;
#pragma unroll
        for (int d = 0; d < 4; ++d)
#pragma unroll
            for (int r = 0; r < 16; ++r) { const float v = o[d][r] - lam * xb[(d * 16 + r) * 64 + lane]; o[d][r] = v; ss += v * v; }
        ss += partner32(ss, hb);
        const float rs = rsqrtf(ss * (1.0f / 128.0f) + RMS_EPS) * (1.0f - LAM_INIT0);
        bf16_t* op = mix + (row0 + qrow) * DM + 512 + 128 * h;
#pragma unroll
        for (int d = 0; d < 4; ++d)
#pragma unroll
            for (int g4 = 0; g4 < 4; ++g4) { const int dd = 32 * d + 8 * g4 + 4 * hb; const f32x4 gv = *(const f32x4*)(sg + dd);
                pg8::st_bf16x4(op + dd, (f32x4){o[d][4 * g4] * rs * gv[0], o[d][4 * g4 + 1] * rs * gv[1], o[d][4 * g4 + 2] * rs * gv[2], o[d][4 * g4 + 3] * rs * gv[3]}); }
    }
    __syncthreads();
}

__device__ __forceinline__ void sb_unit(const Frame& F, int b, int h, int qblk, const bf16_t* P1, bf16_t* mix) {
    const int lane = F.lane, wid = F.wave, r32 = lane & 31, hb = lane >> 5;
    const size_t row0 = (size_t)b * SEQ;
    const int q0 = qblk * 256, qw0 = q0 + 32 * wid, qrow = qw0 + r32, nt = 4 * qblk + 4;
    bf16x8 qf[4];
    { const bf16_t* qp = P1 + (row0 + qrow) * 2048 + 64 * h + 8 * hb;
#pragma unroll
      for (int d0 = 0; d0 < 4; ++d0) qf[d0] = *(const bf16x8*)(qp + 16 * d0); }
    const bf16_t* src0; int dst0, sstep;
    if (wid < 4) { src0 = P1 + (row0 + lane) * 2048 + 512 + 64 * h + 16 * wid; sstep = 8; dst0 = wid * 2048; }
    else { const int w4 = wid - 4; src0 = P1 + (row0 + 32 * (w4 & 1) + 8 * (lane >> 5) + ((lane >> 2) & 7)) * 2048 + 1024 + 64 * h + 32 * (w4 >> 1) + 8 * (lane & 3); sstep = 16 * 2048; dst0 = 8192 + (w4 >> 1) * 4096 + (w4 & 1) * 2048; }
#define SB_ISSUE(t, stg) do { const bf16_t* s_ = src0 + (size_t)(t) * 64 * 2048; LAS unsigned char* d_ = F.lds + (stg) * 16384 + dst0; \
        GLDS16(s_, d_); GLDS16(s_ + sstep, d_ + 1024); } while (0)
    f32x16 o[2];
#pragma unroll
    for (int d = 0; d < 2; ++d)
#pragma unroll
        for (int r = 0; r < 16; ++r) o[d][r] = 0.f;
    float carry = 0.f;
    const int vlane = (4 * hb + ((lane & 15) >> 2)) * 64 + ((lane >> 4) & 1) * 32 + (lane & 3) * 8;
    SB_ISSUE(nt - 1, 0);
    for (int it = 0; it < nt; ++it) {
        const int t = nt - 1 - it;
        VM_WAIT(); __syncthreads();
        if (t > 0) SB_ISSUE(t - 1, (it + 1) & 1);
        const LAS unsigned char* sb = F.lds + (it & 1) * 16384;
        const int kv0 = 64 * t;
        if (kv0 <= qw0) {
            f32x16 p0, p1;
#pragma unroll
            for (int r = 0; r < 16; ++r) { p0[r] = 0.f; p1[r] = 0.f; }
            const LAS unsigned char* kb = sb + hb * 1024 + r32 * 16;
#pragma unroll
            for (int d0 = 0; d0 < 4; ++d0) { const bf16x8 a0 = *(const LAS bf16x8*)(kb + d0 * 2048), a1 = *(const LAS bf16x8*)(kb + d0 * 2048 + 512);
                p0 = __builtin_amdgcn_mfma_f32_32x32x16_bf16(a0, qf[d0], p0, 0, 0, 0); p1 = __builtin_amdgcn_mfma_f32_32x32x16_bf16(a1, qf[d0], p1, 0, 0, 0); }
            const bool diag = (kv0 + 63 >= qw0);
            f32x16 l0, l1;
#pragma unroll
            for (int r = 0; r < 16; ++r) {
                { const float z = p0[r], sp = fmaxf(z, 0.f) + lg2(1.0f + ex2(-fabsf(z))); const bool ok = !diag || (kv0 + crow(r, hb) < qrow); l0[r] = ok ? -sp : 0.f; p0[r] = ok ? z - sp : -INFINITY; }
                { const float z = p1[r], sp = fmaxf(z, 0.f) + lg2(1.0f + ex2(-fabsf(z))); const bool ok = !diag || (kv0 + 32 + crow(r, hb) < qrow); l1[r] = ok ? -sp : 0.f; p1[r] = ok ? z - sp : -INFINITY; }
            }
            float Tq[8], Tp[8], U[8], SU[8];
#pragma unroll
            for (int g4 = 0; g4 < 4; ++g4) { Tq[g4] = (l0[4 * g4] + l0[4 * g4 + 1]) + (l0[4 * g4 + 2] + l0[4 * g4 + 3]); Tq[4 + g4] = (l1[4 * g4] + l1[4 * g4 + 1]) + (l1[4 * g4 + 2] + l1[4 * g4 + 3]); }
#pragma unroll
            for (int k = 0; k < 8; ++k) { Tp[k] = partner32(Tq[k], hb); U[k] = Tq[k] + Tp[k]; }
            SU[7] = 0.f;
#pragma unroll
            for (int k = 6; k >= 0; --k) SU[k] = SU[k + 1] + U[k + 1];
#pragma unroll
            for (int k = 0; k < 8; ++k) {
                const float base = carry + SU[k] + (hb ? 0.f : Tp[k]);
                if (k < 4) { const int q = 4 * k; const float s3 = base, s2 = s3 + l0[q + 3], s1 = s2 + l0[q + 2], s0 = s1 + l0[q + 1];
                    p0[q] = ex2(p0[q] + s0); p0[q + 1] = ex2(p0[q + 1] + s1); p0[q + 2] = ex2(p0[q + 2] + s2); p0[q + 3] = ex2(p0[q + 3] + s3); }
                else { const int q = 4 * (k - 4); const float s3 = base, s2 = s3 + l1[q + 3], s1 = s2 + l1[q + 2], s0 = s1 + l1[q + 1];
                    p1[q] = ex2(p1[q] + s0); p1[q + 1] = ex2(p1[q + 1] + s1); p1[q + 2] = ex2(p1[q + 2] + s2); p1[q + 3] = ex2(p1[q + 3] + s3); }
            }
            carry += SU[0] + U[0];
            const bf16x8 pf0 = pack8(p0, 0), pf1 = pack8(p0, 8), pf2 = pack8(p1, 0), pf3 = pack8(p1, 8);
            const LAS unsigned char* vb = sb + 8192 + vlane;
#pragma unroll
            for (int d = 0; d < 2; ++d) {
                o[d] = __builtin_amdgcn_mfma_f32_32x32x16_bf16(vfrag(vb + d * 4096), pf0, o[d], 0, 0, 0);
                o[d] = __builtin_amdgcn_mfma_f32_32x32x16_bf16(vfrag(vb + d * 4096 + 1024), pf1, o[d], 0, 0, 0);
                o[d] = __builtin_amdgcn_mfma_f32_32x32x16_bf16(vfrag(vb + d * 4096 + 2048), pf2, o[d], 0, 0, 0);
                o[d] = __builtin_amdgcn_mfma_f32_32x32x16_bf16(vfrag(vb + d * 4096 + 3072), pf3, o[d], 0, 0, 0);
            }
        }
    }
#undef SB_ISSUE
    bf16_t* op = mix + (row0 + qrow) * DM + 64 * h;
#pragma unroll
    for (int d = 0; d < 2; ++d)
#pragma unroll
        for (int g4 = 0; g4 < 4; ++g4) pg8::st_bf16x4(op + 32 * d + 8 * g4 + 4 * hb, (f32x4){o[d][4 * g4], o[d][4 * g4 + 1], o[d][4 * g4 + 2], o[d][4 * g4 + 3]});
    __syncthreads();
}
#undef GLDS16
}

enum Phase { PH_PRO = 0, PH_IN0 = 1, PH_MIX0 = 2, PH_OUT0 = 3, PH_LN0 = 4, PH_GU0 = 5, PH_DN0 = 6, PH_FFN0 = 7, PH_IN1 = 8, PH_MIX1 = 9, PH_OUT1 = 10, PH_LN1 = 11, PH_GU1 = 12, PH_DN1 = 13, PH_FFN1 = 14, PH_N = 15 };


#define XB_TMO      128
#define XB_XCNT(j)  (256  + 64 * (j))
#define XB_XSUB(j)  (1280 + 64 * (j))
#define XB_XGEN(j)  (2304 + 64 * (j))
#define XB_TOP      3328
#define XB_TOPGEN   3392
#define XCD_BAR_WORDS 3456
#define XB_SPIN_CAP (1u << 18)
constexpr int CW_BAR = 4096;
__device__ __forceinline__ unsigned xb_ld(unsigned* p)              { return __hip_atomic_load(p, __ATOMIC_RELAXED, __HIP_MEMORY_SCOPE_AGENT); }
__device__ __forceinline__ unsigned xb_add(unsigned* p, unsigned v) { return __hip_atomic_fetch_add(p, v, __ATOMIC_RELAXED, __HIP_MEMORY_SCOPE_AGENT); }
__device__ __forceinline__ unsigned xb_xcc_id() { return (unsigned)__builtin_amdgcn_s_getreg((3 << 11) | 20) & 0xFu; }
#define XB_SPIN(cond, bar) do { unsigned _sp = 0; while (cond) { __builtin_amdgcn_s_sleep(1); \
    if ((++_sp & 255u) == 0u) { if (xb_ld(&(bar)[XB_TMO])) break; if (_sp > XB_SPIN_CAP) { atomicAdd(&(bar)[XB_TMO], 1u); break; } } } } while (0)
struct XcdBarrier { unsigned* bar; unsigned x; volatile LAS unsigned* st; };
__device__ __forceinline__ XcdBarrier xcd_barrier_post(unsigned* bar, volatile LAS unsigned* st) {
    XcdBarrier b; b.bar = bar; b.x = xb_xcc_id(); b.st = st;
    if (threadIdx.x == 0) (void)xb_add(&bar[XB_XCNT(b.x)], 1u);
    return b;
}
__device__ __forceinline__ void xcd_barrier_complete(unsigned* bar, unsigned x, unsigned& nloc, unsigned& nx) {
    const unsigned G = gridDim.x * gridDim.y * gridDim.z;
    unsigned sum, cnt, mine, sp = 0u;
    for (;;) {
        sum = 0u; cnt = 0u; mine = 0u;
#pragma unroll
        for (unsigned j = 0; j < 16; ++j) { const unsigned c = xb_ld(&bar[XB_XCNT(j)]); sum += c; cnt += (c > 0u) ? 1u : 0u; mine = (j == x) ? c : mine; }
        if (sum == G) break;
        __builtin_amdgcn_s_sleep(1);
        if ((++sp & 255u) == 0u) { if (xb_ld(&bar[XB_TMO])) break; if (sp > XB_SPIN_CAP) { atomicAdd(&bar[XB_TMO], 1u); break; } }
    }
    nloc = mine > 0u ? mine : 1u; nx = cnt > 0u ? cnt : 1u;
}
__device__ __forceinline__ void xcd_barrier(const XcdBarrier& b) {
    asm volatile("s_waitcnt vmcnt(0)" ::: "memory");
    __syncthreads();
    if (threadIdx.x == 0) {
        unsigned* bar = b.bar;
        __builtin_amdgcn_s_waitcnt(0);
        unsigned nloc = b.st[0], nx = b.st[1];
        if (nloc == 0u) { xcd_barrier_complete(bar, b.x, nloc, nx); b.st[0] = nloc; b.st[1] = nx; }
        const unsigned old = xb_add(&bar[XB_XSUB(b.x)], 1u);
        const unsigned gen = old / nloc;
        if (old + 1u == (gen + 1u) * nloc) {
            __builtin_amdgcn_fence(__ATOMIC_RELEASE, "agent");
            asm volatile("s_waitcnt vmcnt(0)" ::: "memory");
            const unsigned og = xb_add(&bar[XB_TOP], 1u);
            const unsigned tg = og / nx;
            if (og + 1u == (tg + 1u) * nx) xb_add(&bar[XB_TOPGEN], 1u);
            else XB_SPIN(xb_ld(&bar[XB_TOPGEN]) == tg, bar);
            __builtin_amdgcn_fence(__ATOMIC_ACQUIRE, "agent");
            xb_add(&bar[XB_XGEN(b.x)], 1u);
            asm volatile("s_waitcnt vmcnt(0)" ::: "memory");
        } else {
            XB_SPIN(xb_ld(&bar[XB_XGEN(b.x)]) == gen, bar);
            __builtin_amdgcn_fence(__ATOMIC_ACQUIRE, "agent");
            asm volatile("s_waitcnt vmcnt(0)" ::: "memory");
        }
    }
    __syncthreads();
}

__global__ void __launch_bounds__(NTHREADS, 2) mk_fwd(Args args) {
    extern __shared__ __attribute__((aligned(16))) unsigned char lds_raw[];
    Frame F; F.lds = (LAS unsigned char*)lds_raw; F.tid = threadIdx.x; F.lane = F.tid & 63; F.wave = __builtin_amdgcn_readfirstlane(F.tid >> 6);
    F.G = gridDim.x; { const int bx = blockIdx.x; F.vcu = (F.G % 8 == 0) ? (bx % 8) * (F.G / 8) + bx / 8 : bx; }
    unsigned char* ws = args.ws;
    const int lo = args.ph_lo, hi = args.ph_hi;
    if (F.tid < 128) ((LAS unsigned*)(F.lds + MISC_OFF))[F.tid] = 0u;
    __syncthreads();
    XcdBarrier bar; bar.bar = (unsigned*)(ws + WS_CTL) + CW_BAR; bar.x = 0; bar.st = nullptr;
    if (hi - lo > 1) bar = xcd_barrier_post((unsigned*)(ws + WS_CTL) + CW_BAR, (volatile LAS unsigned*)(F.lds + MISC_OFF + 256));
#define IN(k) (lo <= (k) && (k) < hi)
#define SEAM(k) do { if (IN(k) && IN((k) + 1)) xcd_barrier(bar); } while (0)
    bf16_t* XB = (bf16_t*)(ws + WS_XB); bf16_t* PBUF = (bf16_t*)(ws + WS_PBUF); bf16_t* MIX = (bf16_t*)(ws + WS_MIX); bf16_t* X1B = (bf16_t*)(ws + WS_X1B);
    int* ltok = (int*)(ws + WS_LTOK); float* lgate = (float*)(ws + WS_LGATE); int* cntw = (int*)(ws + WS_CTL) + CW_CNT;
    LAS int* tab = (LAS int*)(F.lds + MISC_OFF);
#define MOE_TABLE(LAYER) do { if (F.tid == 0) { const int* cg = cntw + 64 * (LAYER); int p = 0, r = 0; \
        for (int e = 0; e < 16; ++e) { const int c = cg[e]; tab[e] = c; tab[16 + e] = p; tab[33 + e] = r; p += (c + 255) >> 8; r += c; } tab[32] = p; tab[49] = r; } \
        __syncthreads(); } while (0)

    if (IN(PH_PRO)) { p0_prologue(F, args); }
    SEAM(PH_PRO);
    if (IN(PH_IN0)) {
        pg8::DenseSched S; S.init(XB, (const bf16_t*)(ws + WT_IN0), T_TOK, 2560, 1024, F.G, (int)blockIdx.x);
        pg8::EpiIn0F E{PBUF, (const float2*)(ws + WS_ROPE)};
        pg8::gemm_phase<pg8::EpiIn0F, pg8::DenseSched, false, true>(F.lds, 1024, S, E);
    }
    SEAM(PH_IN0);
    if (IN(PH_MIX0)) {
        for (int u = F.vcu; u < T_TOK / 32; u += F.G) conv_unit(F, u, PBUF, args.in[4], args.in[5], args.in[6], args.in[7], MIX);
        __syncthreads();
        const float d1 = wave_sum(args.in[8][F.lane] * args.in[9][F.lane]), d2 = wave_sum(args.in[10][F.lane] * args.in[11][F.lane]);
        const float lam = expf(d1) - expf(d2) + LAM_INIT0;
        for (int p = F.vcu; p < 256; p += F.G) { const int bh = p >> 3, sidx = p & 7;
            att::diff_unit(F, bh >> 2, bh & 3, 15 - sidx, PBUF + (size_t)T_TOK * 512, PBUF + (size_t)2 * T_TOK * 512, PBUF + (size_t)3 * T_TOK * 512, lam, args.in[12], MIX);
            att::diff_unit(F, bh >> 2, bh & 3, sidx, PBUF + (size_t)T_TOK * 512, PBUF + (size_t)2 * T_TOK * 512, PBUF + (size_t)3 * T_TOK * 512, lam, args.in[12], MIX); }
    }
    SEAM(PH_MIX0);
    if (IN(PH_OUT0)) {
        pg8::DenseSched S; S.init(MIX, (const bf16_t*)(ws + WT_OUT0), T_TOK, 1024, 1024, F.G, (int)blockIdx.x);
        pg8::EpiResF E{PBUF, XB};
        pg8::gemm_phase<pg8::EpiResF, pg8::DenseSched, false, true>(F.lds, 1024, S, E);
    }
    SEAM(PH_OUT0);
    if (IN(PH_LN0)) ph_ln_router(F, PBUF, args.in[14], args.in[15], args.in[1], args.in[2], X1B, ltok, lgate, cntw);
    SEAM(PH_LN0);
    if (IN(PH_GU0) || IN(PH_DN0)) MOE_TABLE(0);
    if (IN(PH_GU0)) { pg8::MoeSched S{X1B, (const bf16_t*)(ws + WT_GU0), ltok, tab, 1024, 4, F.G, (int)blockIdx.x, true};
        pg8::EpiGUF E{PBUF, lgate};
        pg8::gemm_phase<pg8::EpiGUF, pg8::MoeSched, true, true>(F.lds, 1024, S, E); }
    SEAM(PH_GU0);
    if (IN(PH_DN0)) { pg8::MoeSched S{PBUF, (const bf16_t*)(ws + WT_D0), ltok, tab, 512, 4, F.G, (int)blockIdx.x, false};
        pg8::EpiDownF E{MIX, (long)(XB - MIX), ltok};
        pg8::gemm_phase<pg8::EpiDownF, pg8::MoeSched, false, true>(F.lds, 512, S, E); }
    SEAM(PH_DN0);
    if (IN(PH_FFN0)) ph_ln_ffn(F, X1B, MIX, XB, args.in[19], args.in[20], XB, nullptr);
    SEAM(PH_FFN0);
    if (IN(PH_IN1)) {
        pg8::DenseSched S; S.init(XB, (const bf16_t*)(ws + WT_IN1), T_TOK, 2048, 1024, F.G, (int)blockIdx.x);
        pg8::EpiPlainF E{PBUF, 2048, 512, QSCALE};
        pg8::gemm_phase<pg8::EpiPlainF, pg8::DenseSched, false, true>(F.lds, 1024, S, E);
    }
    SEAM(PH_IN1);
    if (IN(PH_MIX1)) {
        for (int u = F.vcu; u < T_TOK / 64; u += F.G) pool_unit(F, u, PBUF, MIX);
        for (int p = F.vcu; p < 256; p += F.G) { const int bh = p >> 2, sidx = p & 3;
            att::sb_unit(F, bh >> 3, bh & 7, 7 - sidx, PBUF, MIX);
            att::sb_unit(F, bh >> 3, bh & 7, sidx, PBUF, MIX); }
    }
    SEAM(PH_MIX1);
    if (IN(PH_OUT1)) {
        pg8::DenseSched S; S.init(MIX, (const bf16_t*)(ws + WT_OUT1), T_TOK, 1024, 1024, F.G, (int)blockIdx.x);
        pg8::EpiResF E{PBUF, XB};
        pg8::gemm_phase<pg8::EpiResF, pg8::DenseSched, false, true>(F.lds, 1024, S, E);
    }
    SEAM(PH_OUT1);
    if (IN(PH_LN1)) ph_ln_router(F, PBUF, args.in[25], args.in[26], args.in[1], args.in[2], X1B, ltok, lgate, cntw + 64);
    SEAM(PH_LN1);
    if (IN(PH_GU1) || IN(PH_DN1)) MOE_TABLE(1);
    if (IN(PH_GU1)) { pg8::MoeSched S{X1B, (const bf16_t*)(ws + WT_GU1), ltok, tab, 1024, 4, F.G, (int)blockIdx.x, true};
        pg8::EpiGUF E{PBUF, lgate};
        pg8::gemm_phase<pg8::EpiGUF, pg8::MoeSched, true, true>(F.lds, 1024, S, E); }
    SEAM(PH_GU1);
    if (IN(PH_DN1)) { pg8::MoeSched S{PBUF, (const bf16_t*)(ws + WT_D1), ltok, tab, 512, 4, F.G, (int)blockIdx.x, false};
        pg8::EpiDownF E{MIX, (long)(XB - MIX), ltok};
        pg8::gemm_phase<pg8::EpiDownF, pg8::MoeSched, false, true>(F.lds, 512, S, E); }
    SEAM(PH_DN1);
    if (IN(PH_FFN1)) ph_ln_ffn(F, X1B, MIX, XB, args.in[30], args.in[31], nullptr, args.out);
#undef IN
#undef SEAM
#undef MOE_TABLE
}

extern "C" void kernel_launch(void* const* d_in, const int* in_sizes, int n_in, void* d_out, int out_size, void* d_ws, size_t ws_size, hipStream_t stream) {
    if (n_in != 32 || ws_size < WS_END || out_size != T_TOK * DM) { fprintf(stderr, "kernel_launch: unexpected problem (n_in %d ws %zu out %d)\n", n_in, ws_size, out_size); return; }
    static int grid = 0;
    if (grid == 0) {
        int dev = 0, cus = 0;
        if (hipGetDevice(&dev) != hipSuccess || hipDeviceGetAttribute(&cus, hipDeviceAttributeMultiprocessorCount, dev) != hipSuccess) { grid = -1; return; }
        if (hipFuncSetAttribute((const void*)mk_fwd, hipFuncAttributeMaxDynamicSharedMemorySize, LDS_BYTES) != hipSuccess) { fprintf(stderr, "hipFuncSetAttribute failed\n"); grid = -1; return; }
        grid = cus;
    }
    if (grid < 0) return;
    const float* const* in = (const float* const*)d_in;
    unsigned char* ws = (unsigned char*)d_ws;
    (void)hipMemsetAsync(ws + WS_CTL, 0, 1 * MiB, stream);
    int* ctl = (int*)(ws + WS_CTL);
    float2* rope = (float2*)(ws + WS_ROPE);
    int4* topk = (int4*)(ws + WS_TOPK);
    int* ltok = (int*)(ws + WS_LTOK); float* lgate = (float*)(ws + WS_LGATE);
    float* wfold = (float*)(ws + WS_WFOLD);
    bf16_t* XB = (bf16_t*)(ws + WS_XB); bf16_t* PBUF = (bf16_t*)(ws + WS_PBUF); bf16_t* MIX = (bf16_t*)(ws + WS_MIX); bf16_t* X1B = (bf16_t*)(ws + WS_X1B);
    bf16_t* Y = PBUF; bf16_t* YS0 = MIX; bf16_t* YS1 = XB;
    Args a{};
    for (int i = 0; i < 32; ++i) a.in[i] = in[i];
    a.out = (float*)d_out; a.ws = ws;
    auto phases = [&](int lo, int hi) { a.ph_lo = lo; a.ph_hi = hi; hipLaunchKernelGGL(mk_fwd, dim3(grid), dim3(NTHREADS), LDS_BYTES, stream, a); };
    (void)rope; (void)wfold; (void)topk; (void)ltok; (void)lgate; (void)ctl; (void)Y; (void)YS0; (void)YS1; (void)X1B; (void)MIX; (void)PBUF; (void)XB;

    phases(PH_PRO, PH_N);
}
```

```cpp
#include <hip/hip_runtime.h>
#include <cstdint>
#include <cstdio>

typedef unsigned short bf16_t;

constexpr int T_TOK = 16384, DM = 1024, SEQ = 2048, NB = 8;
constexpr int NE = 16, DFF = 512;
constexpr float ALPHA = 1.41421356237f;
constexpr float LN_EPS = 1e-5f, RMS_EPS = 1e-5f;
constexpr float LOG2E = 1.4426950408889634f;
constexpr float QSCALE = 0.125f * LOG2E;
constexpr float LAM_INIT0 = 0.2f;

constexpr size_t MiB = 1u << 20;
constexpr size_t WS_CTL = 0;
constexpr size_t WS_ROPE = 1 * MiB;
constexpr size_t WS_TOPK = 2 * MiB;
constexpr size_t WS_LTOK = 3 * MiB;
constexpr size_t WS_LGATE = 4 * MiB;
constexpr size_t WS_WFOLD = 243 * MiB;
constexpr size_t WS_WT = 6 * MiB;
constexpr size_t WS_XB = 115 * MiB;
constexpr size_t WS_PBUF = 147 * MiB;
constexpr size_t WS_MIX = 211 * MiB;
constexpr size_t WS_X1B = 243 * MiB;
constexpr size_t WS_END = 275 * MiB;

constexpr int CW_CNT = 8192;

__device__ __forceinline__ float bf2f(bf16_t v) { return __uint_as_float(((unsigned)v) << 16); }
__device__ __forceinline__ bf16_t f2bf(float f) { unsigned u = __float_as_uint(f); return (bf16_t)((u + 0x7fffu + ((u >> 16) & 1u)) >> 16); }
__device__ __forceinline__ float sigmoidf_(float x) { return 1.0f / (1.0f + __expf(-x)); }
__device__ __forceinline__ float wave_sum(float v) {
#pragma unroll
    for (int o = 1; o < 64; o <<= 1) v += __shfl_xor(v, o);
    return v;
}

__global__ void k_cvt_bf16(const float* __restrict__ x, bf16_t* __restrict__ o, size_t n) {
    size_t i = (size_t)blockIdx.x * blockDim.x + threadIdx.x;
    if (i < n) o[i] = f2bf(x[i]);
}
__global__ void k_rope_table(float2* cs) {
    int i = blockIdx.x * blockDim.x + threadIdx.x; if (i >= SEQ * 32) return;
    int pos = i / 32, f = i % 32;
    float inv = powf(10000.0f, -(float)(2 * f) / 64.0f);
    float ang = (float)pos * inv;
    float s, c; sincosf(ang, &s, &c);
    cs[i] = make_float2(c, s);
}

template <bool PAIR, class Epi>
__global__ __launch_bounds__(256) void k_gemm_naive(const bf16_t* __restrict__ A, int lda, const float* __restrict__ W, int ldw, int K, Epi epi) {
    __shared__ float As[16][65];
    __shared__ float Wa[16][65];
    __shared__ float Wb[16][65];
    const int tid = threadIdx.x, tx = tid & 15, ty = tid >> 4;
    const int m0 = blockIdx.y * 64, j0 = blockIdx.x * 64;
    float accA[4][4], accB[4][4];
#pragma unroll
    for (int i = 0; i < 4; ++i)
#pragma unroll
        for (int j = 0; j < 4; ++j) { accA[i][j] = 0.f; accB[i][j] = 0.f; }
    for (int k0 = 0; k0 < K; k0 += 16) {
        for (int i = tid; i < 1024; i += 256) { int r = i >> 4, kk = i & 15; As[kk][r] = bf2f(A[(size_t)(m0 + r) * lda + k0 + kk]); }
        for (int i = tid; i < 1024; i += 256) { int kk = i >> 6, jj = i & 63;
            Wa[kk][jj] = W[(size_t)(k0 + kk) * ldw + epi.colA(j0 + jj)];
            if (PAIR) Wb[kk][jj] = W[(size_t)(k0 + kk) * ldw + epi.colB(j0 + jj)]; }
        __syncthreads();
#pragma unroll
        for (int kk = 0; kk < 16; ++kk) {
            float a[4], b[4], c[4];
#pragma unroll
            for (int i = 0; i < 4; ++i) a[i] = As[kk][ty * 4 + i];
#pragma unroll
            for (int j = 0; j < 4; ++j) { b[j] = Wa[kk][tx * 4 + j]; c[j] = PAIR ? Wb[kk][tx * 4 + j] : 0.f; }
#pragma unroll
            for (int i = 0; i < 4; ++i)
#pragma unroll
                for (int j = 0; j < 4; ++j) { accA[i][j] += a[i] * b[j]; if (PAIR) accB[i][j] += a[i] * c[j]; }
        }
        __syncthreads();
    }
#pragma unroll
    for (int i = 0; i < 4; ++i)
#pragma unroll
        for (int j = 0; j < 4; ++j) epi.store(m0 + ty * 4 + i, j0 + tx * 4 + j, accA[i][j], accB[i][j]);
}

struct EpiIn0 {
    bf16_t* pbuf; const float2* cs;
    __device__ int colA(int j) const { if (j < 512) return j; if (j < 1024) return 1024 + (j - 512); if (j < 1536) return 1536 + (j - 1024); return 2048 + (j - 1536); }
    __device__ int colB(int j) const { if (j < 512) return 512 + j; if (j < 1024) return 1024 + ((j - 512) ^ 32); if (j < 1536) return 1536 + ((j - 1024) ^ 32); return 2048 + (j - 1536); }
    __device__ void store(int m, int j, float a, float b) const {
        const int reg = j >> 9, jj = j & 511; float o;
        if (reg == 0) o = a * sigmoidf_(b);
        else if (reg == 3) o = a;
        else { const int d = jj & 63, pos = m & (SEQ - 1); const float2 c = cs[pos * 32 + (d & 31)];
            o = (d < 32) ? a * c.x - b * c.y : a * c.x + b * c.y; if (reg == 1) o *= QSCALE; }
        pbuf[(size_t)reg * T_TOK * 512 + (size_t)m * 512 + jj] = f2bf(o);
    }
};
struct EpiIn1 {
    bf16_t* p1;
    __device__ int colA(int j) const { return j; }
    __device__ int colB(int j) const { return j; }
    __device__ void store(int m, int j, float a, float) const { p1[(size_t)m * 2048 + j] = f2bf(j < 512 ? a * QSCALE : a); }
};
struct EpiOut {
    bf16_t* y; const bf16_t* xb;
    __device__ int colA(int j) const { return j; }
    __device__ int colB(int j) const { return j; }
    __device__ void store(int m, int j, float a, float) const { y[(size_t)m * DM + j] = f2bf(ALPHA * bf2f(xb[(size_t)m * DM + j]) + a); }
};

__global__ __launch_bounds__(512) void k_conv_naive(const bf16_t* __restrict__ aglu, const float* __restrict__ cw, const float* __restrict__ cb,
                                                   const float* __restrict__ g, const float* __restrict__ b, bf16_t* __restrict__ mix) {
    __shared__ float red[16];
    const int t = blockIdx.x, c = threadIdx.x, pos = t & (SEQ - 1);
    float acc = cb[c];
    for (int w = 0; w < 31; ++w) { const int p = pos - 30 + w; if (p >= 0) acc += bf2f(aglu[(size_t)(t - 30 + w) * 512 + c]) * cw[w * 512 + c]; }
    float s = wave_sum(acc);
    if ((c & 63) == 0) red[c >> 6] = s;
    __syncthreads();
    float tot = 0.f;
    for (int i = 0; i < 8; ++i) tot += red[i];
    const float mean = tot * (1.0f / 512.0f), d = acc - mean;
    float q = wave_sum(d * d);
    if ((c & 63) == 0) red[8 + (c >> 6)] = q;
    __syncthreads();
    float tq = 0.f;
    for (int i = 0; i < 8; ++i) tq += red[8 + i];
    const float rstd = rsqrtf(tq * (1.0f / 512.0f) + LN_EPS);
    const float y = d * rstd * g[c] + b[c];
    mix[(size_t)t * DM + c] = f2bf(y * sigmoidf_(y));
}

__global__ __launch_bounds__(256) void k_diffattn_naive(const bf16_t* __restrict__ Q, const bf16_t* __restrict__ Kt, const bf16_t* __restrict__ V, bf16_t* __restrict__ obuf) {
    __shared__ float Qs[32][65];
    __shared__ float Ks[32][65];
    __shared__ float Vs[32][129];
    __shared__ float Ps[32][33];
    const int tid = threadIdx.x, tx = tid & 7, ty = tid >> 3;
    const int qb = blockIdx.x, bh = blockIdx.y, st = blockIdx.z, b = bh >> 2, h = bh & 3;
    const size_t row0 = (size_t)b * SEQ;
    const int q0 = qb * 32, colqk = h * 128 + st * 64, colv = h * 128;
    for (int i = tid; i < 32 * 64; i += 256) { int r = i >> 6, d = i & 63; Qs[r][d] = bf2f(Q[(row0 + q0 + r) * 512 + colqk + d]); }
    float m = -INFINITY, l = 0.f, o[16];
#pragma unroll
    for (int c = 0; c < 16; ++c) o[c] = 0.f;
    const int qrow = q0 + ty;
    for (int j0 = 0; j0 <= q0; j0 += 32) {
        __syncthreads();
        for (int i = tid; i < 32 * 64; i += 256) { int r = i >> 6, d = i & 63; Ks[r][d] = bf2f(Kt[(row0 + j0 + r) * 512 + colqk + d]); }
        for (int i = tid; i < 32 * 128; i += 256) { int r = i >> 7, d = i & 127; Vs[r][d] = bf2f(V[(row0 + j0 + r) * 512 + colv + d]); }
        __syncthreads();
        float s[4], mx = -INFINITY;
#pragma unroll
        for (int i = 0; i < 4; ++i) { const int kk = tx + 8 * i; float a = 0.f;
            for (int d = 0; d < 64; ++d) a += Qs[ty][d] * Ks[kk][d];
            if (j0 + kk > qrow) a = -INFINITY; s[i] = a; mx = fmaxf(mx, a); }
        mx = fmaxf(mx, __shfl_xor(mx, 1)); mx = fmaxf(mx, __shfl_xor(mx, 2)); mx = fmaxf(mx, __shfl_xor(mx, 4));
        const float mn = fmaxf(m, mx), alpha = exp2f(m - mn);
        float ps = 0.f;
#pragma unroll
        for (int i = 0; i < 4; ++i) { const float p = exp2f(s[i] - mn); ps += p; Ps[ty][tx + 8 * i] = p; }
        ps += __shfl_xor(ps, 1); ps += __shfl_xor(ps, 2); ps += __shfl_xor(ps, 4);
        l = l * alpha + ps; m = mn;
        __syncthreads();
#pragma unroll
        for (int c = 0; c < 16; ++c) { const int d = tx + 8 * c; float a = o[c] * alpha;
            for (int kk = 0; kk < 32; ++kk) a += Ps[ty][kk] * Vs[kk][d];
            o[c] = a; }
    }
    const float il = 1.0f / l;
#pragma unroll
    for (int c = 0; c < 16; ++c) obuf[(size_t)st * T_TOK * 512 + (row0 + qrow) * 512 + colv + tx + 8 * c] = f2bf(o[c] * il);
}
__global__ __launch_bounds__(512) void k_diffcombine_naive(const bf16_t* __restrict__ obuf, const float* lq1, const float* lk1, const float* lq2, const float* lk2,
                                                          const float* __restrict__ sg, bf16_t* __restrict__ mix) {
    const int t = blockIdx.x, c = threadIdx.x, lane = c & 63;
    const float d1 = wave_sum(lq1[lane] * lk1[lane]), d2 = wave_sum(lq2[lane] * lk2[lane]);
    const float lam = expf(d1) - expf(d2) + LAM_INIT0;
    const float o = bf2f(obuf[(size_t)t * 512 + c]) - lam * bf2f(obuf[(size_t)T_TOK * 512 + (size_t)t * 512 + c]);
    float ss = wave_sum(o * o);
    __shared__ float red[8];
    if (lane == 0) red[c >> 6] = ss;
    __syncthreads();
    const int hw = (c >> 7) * 2;
    const float tot = red[hw] + red[hw + 1];
    const float r = rsqrtf(tot * (1.0f / 128.0f) + RMS_EPS);
    mix[(size_t)t * DM + 512 + c] = f2bf(o * r * sg[c & 127] * (1.0f - LAM_INIT0));
}

__global__ __launch_bounds__(256) void k_sbattn_naive(const bf16_t* __restrict__ P1, bf16_t* __restrict__ mix) {
    __shared__ float Qs[32][65];
    __shared__ float Ks[32][65];
    __shared__ float Vs[32][65];
    __shared__ float Ps[32][33];
    const int tid = threadIdx.x, tx = tid & 7, ty = tid >> 3;
    const int qb = blockIdx.x, bh = blockIdx.y, b = bh >> 3, h = bh & 7;
    const size_t row0 = (size_t)b * SEQ;
    const int q0 = qb * 32;
    for (int i = tid; i < 32 * 64; i += 256) { int r = i >> 6, d = i & 63; Qs[r][d] = bf2f(P1[(row0 + q0 + r) * 2048 + h * 64 + d]); }
    float carry = 0.f, o[8];
#pragma unroll
    for (int c = 0; c < 8; ++c) o[c] = 0.f;
    const int qrow = q0 + ty;
    for (int j0 = q0; j0 >= 0; j0 -= 32) {
        __syncthreads();
        for (int i = tid; i < 32 * 64; i += 256) { int r = i >> 6, d = i & 63;
            Ks[r][d] = bf2f(P1[(row0 + j0 + r) * 2048 + 512 + h * 64 + d]); Vs[r][d] = bf2f(P1[(row0 + j0 + r) * 2048 + 1024 + h * 64 + d]); }
        __syncthreads();
        float ls[4], lb[4]; bool ok[4]; float tsum = 0.f;
#pragma unroll
        for (int i = 0; i < 4; ++i) { const int kk = tx * 4 + i; float z = 0.f;
            for (int d = 0; d < 64; ++d) z += Qs[ty][d] * Ks[kk][d];
            ok[i] = (j0 + kk) < qrow;
            const float sp = fmaxf(z, 0.f) + log2f(1.0f + exp2f(-fabsf(z)));
            ls[i] = ok[i] ? -sp : 0.f; lb[i] = z - sp; tsum += ls[i]; }
        float R = tsum;
        { float v = __shfl_down(R, 1); if (tx + 1 < 8) R += v; }
        { float v = __shfl_down(R, 2); if (tx + 2 < 8) R += v; }
        { float v = __shfl_down(R, 4); if (tx + 4 < 8) R += v; }
        const float tile_total = __shfl(R, (tid & 63) & ~7);
        float suf = carry + (R - tsum);
#pragma unroll
        for (int i = 3; i >= 0; --i) { const float a = ok[i] ? exp2f(lb[i] + suf) : 0.f; Ps[ty][tx * 4 + i] = a; suf += ls[i]; }
        carry += tile_total;
        __syncthreads();
#pragma unroll
        for (int c = 0; c < 8; ++c) { const int d = tx + 8 * c; float a = o[c];
            for (int kk = 0; kk < 32; ++kk) a += Ps[ty][kk] * Vs[kk][d];
            o[c] = a; }
    }
#pragma unroll
    for (int c = 0; c < 8; ++c) mix[(row0 + qrow) * DM + h * 64 + tx + 8 * c] = f2bf(o[c]);
}

__global__ void k_pool_naive(const bf16_t* __restrict__ P1, bf16_t* __restrict__ mix) {
    const size_t i = (size_t)blockIdx.x * blockDim.x + threadIdx.x; if (i >= (size_t)T_TOK * 512) return;
    const int t = (int)(i >> 9), c = (int)(i & 511), g = c >> 7, win = 2 << g, pos = t & (SEQ - 1);
    const int cnt = (pos + 1 < win) ? pos + 1 : win;
    float s = 0.f;
    for (int k = 0; k < cnt; ++k) s += bf2f(P1[(size_t)(t - k) * 2048 + 1536 + c]);
    const float u = bf2f(P1[(size_t)t * 2048 + 1536 + c]);
    mix[(size_t)t * DM + 512 + c] = f2bf(s / (float)cnt - u);
}
__global__ void k_fold_naive(const float* __restrict__ op, const float* __restrict__ pw, const float* __restrict__ ps, float* __restrict__ wf) {
    const int i = blockIdx.x * blockDim.x + threadIdx.x; if (i >= 1024 * 1024) return;
    const int r = i >> 10, n = i & 1023;
    if (r < 512) { wf[i] = op[i]; return; }
    const int g = (r - 512) >> 7, c = (r - 512) & 127;
    float a = 0.f;
    for (int d = 0; d < 128; ++d) a += pw[(g * 128 + c) * 128 + d] * ps[g * 128 + d] * op[(size_t)(512 + g * 128 + d) * 1024 + n];
    wf[i] = a;
}

__global__ __launch_bounds__(256) void k_ln_router_naive(const bf16_t* __restrict__ Y, const float* __restrict__ g, const float* __restrict__ bta,
                                                         const float* __restrict__ rw, const float* __restrict__ rb, bf16_t* __restrict__ x1b,
                                                         int4* __restrict__ topk, int* __restrict__ ltok, float* __restrict__ lgate, int* __restrict__ cnt) {
    const int lane = threadIdx.x & 63, t = blockIdx.x * 4 + (threadIdx.x >> 6);
    float v[16], s = 0.f;
#pragma unroll
    for (int i = 0; i < 16; ++i) { v[i] = bf2f(Y[(size_t)t * DM + lane + 64 * i]); s += v[i]; }
    const float mean = wave_sum(s) * (1.0f / DM);
    float q = 0.f;
#pragma unroll
    for (int i = 0; i < 16; ++i) { v[i] -= mean; q += v[i] * v[i]; }
    const float rstd = rsqrtf(wave_sum(q) * (1.0f / DM) + LN_EPS);
    float lg[16];
#pragma unroll
    for (int e = 0; e < 16; ++e) lg[e] = 0.f;
#pragma unroll
    for (int i = 0; i < 16; ++i) { const int c = lane + 64 * i; const float y = v[i] * rstd * g[c] + bta[c];
        x1b[(size_t)t * DM + c] = f2bf(y);
#pragma unroll
        for (int e = 0; e < 16; ++e) lg[e] += y * rw[c * 16 + e]; }
#pragma unroll
    for (int e = 0; e < 16; ++e) lg[e] = wave_sum(lg[e]);
    if (lane == 0) {
        float aff[16], sel[16];
#pragma unroll
        for (int e = 0; e < 16; ++e) { aff[e] = 1.0f / (1.0f + expf(-lg[e])); sel[e] = aff[e] + rb[e]; }
        int gb = 0, bi1 = 0, bi2 = 1; float best = -INFINITY;
#pragma unroll
        for (int gi = 0; gi < 4; ++gi) {
            int i1 = 0; float v1 = sel[gi * 4];
#pragma unroll
            for (int k = 1; k < 4; ++k) if (sel[gi * 4 + k] > v1) { v1 = sel[gi * 4 + k]; i1 = k; }
            int i2 = -1; float v2 = -INFINITY;
#pragma unroll
            for (int k = 0; k < 4; ++k) if (k != i1 && sel[gi * 4 + k] > v2) { v2 = sel[gi * 4 + k]; i2 = k; }
            const float sc = v1 + v2;
            if (sc > best) { best = sc; gb = gi; bi1 = i1; bi2 = i2; }
        }
        const int e0 = gb * 4 + bi1, e1 = gb * 4 + bi2;
        float a0 = 0.f, a1 = 0.f;
#pragma unroll
        for (int e = 0; e < 16; ++e) { if (e == e0) a0 = aff[e]; if (e == e1) a1 = aff[e]; }
        const float g0 = a0 / (a0 + a1), g1 = a1 / (a0 + a1);
        topk[t] = make_int4(e0, e1, __float_as_int(g0), __float_as_int(g1));
        const int s0 = atomicAdd(&cnt[e0], 1); ltok[e0 * T_TOK + s0] = t * 2 + 0; lgate[e0 * T_TOK + s0] = g0;
        const int s1 = atomicAdd(&cnt[e1], 1); ltok[e1 * T_TOK + s1] = t * 2 + 1; lgate[e1 * T_TOK + s1] = g1;
    }
}

__global__ __launch_bounds__(256) void k_moe_naive(const bf16_t* __restrict__ x1b, const int4* __restrict__ topk, const float* __restrict__ wg, const float* __restrict__ wu,
                                                   const float* __restrict__ wd, bf16_t* __restrict__ ys0, bf16_t* __restrict__ ys1) {
    __shared__ float xs[DM];
    __shared__ float hs[DFF];
    const int t = blockIdx.x, tid = threadIdx.x;
    for (int i = tid; i < DM; i += 256) xs[i] = bf2f(x1b[(size_t)t * DM + i]);
    const int4 tk = topk[t];
    for (int k = 0; k < 2; ++k) {
        const int e = k ? tk.y : tk.x; const float gate = __int_as_float(k ? tk.w : tk.z);
        __syncthreads();
        const float* G = wg + (size_t)e * DM * DFF; const float* U = wu + (size_t)e * DM * DFF;
        float g0 = 0.f, g1 = 0.f, u0 = 0.f, u1 = 0.f;
        for (int d = 0; d < DM; ++d) { const float x = xs[d]; g0 += x * G[(size_t)d * DFF + tid]; g1 += x * G[(size_t)d * DFF + tid + 256];
            u0 += x * U[(size_t)d * DFF + tid]; u1 += x * U[(size_t)d * DFF + tid + 256]; }
        hs[tid] = g0 * sigmoidf_(g0) * u0 * gate; hs[tid + 256] = g1 * sigmoidf_(g1) * u1 * gate;
        __syncthreads();
        const float* Dw = wd + (size_t)e * DFF * DM;
        float y[4] = {0.f, 0.f, 0.f, 0.f};
        for (int f = 0; f < DFF; ++f) { const float hv = hs[f];
#pragma unroll
            for (int i = 0; i < 4; ++i) y[i] += hv * Dw[(size_t)f * DM + tid + 256 * i]; }
        bf16_t* ys = k ? ys1 : ys0;
#pragma unroll
        for (int i = 0; i < 4; ++i) ys[(size_t)t * DM + tid + 256 * i] = f2bf(y[i]);
    }
}

__global__ __launch_bounds__(256) void k_ln_ffn_naive(const bf16_t* x1b, const bf16_t* ys0, const bf16_t* ys1, const float* __restrict__ g,
                                                      const float* __restrict__ bta, bf16_t* xb_out, float* fout) {
    const int lane = threadIdx.x & 63, t = blockIdx.x * 4 + (threadIdx.x >> 6);
    float v[16], s = 0.f;
#pragma unroll
    for (int i = 0; i < 16; ++i) { const size_t ix = (size_t)t * DM + lane + 64 * i; v[i] = ALPHA * bf2f(x1b[ix]) + bf2f(ys0[ix]) + bf2f(ys1[ix]); s += v[i]; }
    const float mean = wave_sum(s) * (1.0f / DM);
    float q = 0.f;
#pragma unroll
    for (int i = 0; i < 16; ++i) { v[i] -= mean; q += v[i] * v[i]; }
    const float rstd = rsqrtf(wave_sum(q) * (1.0f / DM) + LN_EPS);
#pragma unroll
    for (int i = 0; i < 16; ++i) { const int c = lane + 64 * i; const float y = v[i] * rstd * g[c] + bta[c]; const size_t ix = (size_t)t * DM + c;
        if (xb_out) xb_out[ix] = f2bf(y); if (fout) fout[ix] = y; }
}


#define LAS __attribute__((address_space(3)))
#define GAS __attribute__((address_space(1)))
typedef short bf16x8 __attribute__((ext_vector_type(8)));
typedef float f32x4 __attribute__((ext_vector_type(4)));
typedef float f32x2 __attribute__((ext_vector_type(2)));
typedef float f32x16 __attribute__((ext_vector_type(16)));
typedef unsigned u32x4 __attribute__((ext_vector_type(4)));
typedef unsigned u32x2 __attribute__((ext_vector_type(2)));
constexpr int NWAVES = 8, NTHREADS = 512;
constexpr int LDS_BYTES = 147456;
constexpr int RING_BYTES = 131072;
constexpr int MISC_OFF = RING_BYTES;

constexpr size_t WT_IN0 = WS_WT;
constexpr size_t WT_OUT0 = WT_IN0 + (size_t)2560 * 1024 * 2;
constexpr size_t WT_GU0 = WT_OUT0 + (size_t)1024 * 1024 * 2;
constexpr size_t WT_D0 = WT_GU0 + (size_t)16 * 1024 * 1024 * 2;
constexpr size_t WT_IN1 = WT_D0 + (size_t)16 * 1024 * 512 * 2;
constexpr size_t WT_OUT1 = WT_IN1 + (size_t)2048 * 1024 * 2;
constexpr size_t WT_GU1 = WT_OUT1 + (size_t)1024 * 1024 * 2;
constexpr size_t WT_D1 = WT_GU1 + (size_t)16 * 1024 * 1024 * 2;
constexpr size_t WT_END = WT_D1 + (size_t)16 * 1024 * 512 * 2;
constexpr size_t WT_FA = 5 * MiB;
constexpr size_t WT_FB = 2 * MiB;
static_assert(WT_END <= WS_XB, "weight copies overflow their region");

__device__ __forceinline__ unsigned cvt_pk_bf16(float lo, float hi) { unsigned r; asm volatile("v_cvt_pk_bf16_f32 %0, %1, %2" : "=v"(r) : "v"(lo), "v"(hi)); return r; }
#define LDS_WAIT() asm volatile("s_waitcnt lgkmcnt(0)" ::: "memory")
#define VM_WAIT() asm volatile("s_waitcnt vmcnt(0)" ::: "memory")

struct Args {
    const float* in[32]; float* out; unsigned char* ws; int ph_lo, ph_hi;
};

namespace pg8 {
constexpr int BM = 256, BK = 64, HALF = 128, HTB = HALF * BK * 2, STAGE_BYTES = 8 * HTB;
static_assert(STAGE_BYTES <= RING_BYTES, "stage buffers");
__host__ __device__ __forceinline__ int lds_byte(int r, int c) { const int st = (r >> 4) * 2 + (c >> 5), rr = r & 15, cc = c & 31, ob = rr * 64 + cc * 2; return st * 1024 + (ob ^ (((ob >> 9) & 1) << 5)); }
__host__ __device__ __forceinline__ void stage_rc(int b, int& R, int& C) { const int st = b / 1024, sb = b % 1024, swz = sb ^ (((sb >> 9) & 1) << 5); R = (st >> 1) * 16 + swz / 64; C = (st & 1) * 32 + (swz % 64) / 2; }
__host__ __device__ __forceinline__ int perm32(int rho) { const int n = rho >> 4, i = rho & 15; return 8 * (i >> 2) + 4 * n + (i & 3); }

struct Unit { int pm, pn, e, cnt, rb; };

template <class Epi, class Sched, bool GATHER, bool ALIGN_EPI>
__device__ __forceinline__ void gemm_phase(LAS unsigned char* lds, const int K, const Sched& S, const Epi& E) {
    const int tid = threadIdx.x, wid = __builtin_amdgcn_readfirstlane(tid >> 6), lane = tid & 63, wr = wid >> 2, wc = wid & 3, fr = lane & 15, fq = lane >> 4;
    const int nt = K / BK;
    unsigned voffB[2], coff0[2], coff1[2], noff0[2], noff1[2]; int RA[2], CA2[2];
#pragma unroll
    for (int i = 0; i < 2; ++i) { int R, C; stage_rc(tid * 16 + i * 8192, R, C); const int Rb = Epi::PERM ? ((R & ~31) + perm32(R & 31)) : R;
        voffB[i] = (unsigned)(Rb * K + C) * 2u; RA[i] = R; CA2[i] = C * 2;
        coff0[i] = (unsigned)(R * K + C) * 2u; coff1[i] = coff0[i] + (unsigned)(HALF * K * 2); noff0[i] = coff0[i]; noff1[i] = coff1[i]; }
    const size_t kstep = (size_t)(BK * 2);
    const size_t hstep = (size_t)HALF * K * 2;
    const unsigned ldsw = (unsigned)wid * 1024u;
    const int aoff = lds_byte(wr * 64 + fr, fq * 8), boff = lds_byte(wc * 32 + fr, fq * 8);
#define PG8_SA(b, h) (((b) * 2 + (h)) * HTB)
#define PG8_SB(b, h) ((4 + (b) * 2 + (h)) * HTB)
#define PG8_STAGE(bufoff, gbase, voff) do { _Pragma("unroll") for (int _i = 0; _i < 2; ++_i) \
        __builtin_amdgcn_global_load_lds((const unsigned*)((const char*)(gbase) + (voff)[_i]), (LAS unsigned*)(lds + (bufoff) + ldsw + _i * 8192), 16, 0, 0); } while (0)
#define PG8_LDA(dst, b, h) do { _Pragma("unroll") for (int m = 0; m < 4; ++m) _Pragma("unroll") for (int k = 0; k < 2; ++k) dst[m][k] = *(const LAS bf16x8*)(lds + PG8_SA(b, h) + aoff + m * 2048 + k * 1024); } while (0)
#define PG8_LDB(dst, b, h) do { _Pragma("unroll") for (int n = 0; n < 2; ++n) _Pragma("unroll") for (int k = 0; k < 2; ++k) dst[n][k] = *(const LAS bf16x8*)(lds + PG8_SB(b, h) + boff + n * 2048 + k * 1024); } while (0)
#define PG8_MMA(ai, bj, At, Bt) do { __builtin_amdgcn_s_setprio(1); _Pragma("unroll") for (int m = 0; m < 4; ++m) _Pragma("unroll") for (int n = 0; n < 2; ++n) _Pragma("unroll") for (int k = 0; k < 2; ++k) \
        acc[ai][bj][m][n] = __builtin_amdgcn_mfma_f32_16x16x32_bf16(Bt[n][k], At[m][k], acc[ai][bj][m][n], 0, 0, 0); __builtin_amdgcn_s_setprio(0); } while (0)
#define PG8_WAIT_V(n) asm volatile("s_waitcnt vmcnt(" #n ")" ::: "memory")
#define PG8_WAIT_L(n) asm volatile("s_waitcnt lgkmcnt(" #n ")" ::: "memory")
#define PG8_BAR __builtin_amdgcn_s_barrier()
#define PG8_SCHED __builtin_amdgcn_sched_barrier(0)
    Unit cur, nxt; int ui = 0;
    if (!S.next(0, cur)) return;
    if constexpr (GATHER) {
        asm volatile("" ::: "memory");
#pragma unroll
        for (int i = 0; i < 2; ++i) { coff0[i] = S.arow(cur, RA[i]) + (unsigned)CA2[i]; coff1[i] = S.arow(cur, HALF + RA[i]) + (unsigned)CA2[i]; }
        VM_WAIT();
        asm volatile("" : "+v"(coff0[0]), "+v"(coff0[1]), "+v"(coff1[0]), "+v"(coff1[1]));
    }
    f32x4 acc[2][2][4][2];
#pragma unroll
    for (int a = 0; a < 2; ++a)
#pragma unroll
        for (int b = 0; b < 2; ++b)
#pragma unroll
            for (int m = 0; m < 4; ++m)
#pragma unroll
                for (int n = 0; n < 2; ++n) acc[a][b][m][n] = (f32x4){0.f, 0.f, 0.f, 0.f};
    bf16x8 At[4][2], B0[2][2], B1[2][2];
    const char* cA = S.abase(cur); const char* cB = S.bbase(cur);
    PG8_STAGE(PG8_SB(0, 0), cB, voffB); PG8_STAGE(PG8_SB(0, 1), cB + hstep, voffB); PG8_STAGE(PG8_SA(0, 0), cA, coff0); PG8_STAGE(PG8_SA(0, 1), cA, coff1);
    if (wr == 1) PG8_BAR;
    PG8_WAIT_V(2); PG8_BAR;
    PG8_STAGE(PG8_SB(1, 0), cB + kstep, voffB); PG8_STAGE(PG8_SA(1, 0), cA + kstep, coff0); PG8_STAGE(PG8_SB(1, 1), cB + hstep + kstep, voffB);
    PG8_WAIT_V(6); PG8_BAR;
    for (;;) {
        const bool has_next = S.next(ui + 1, nxt);
        const char* nA = has_next ? S.abase(nxt) : cA; const char* nB = has_next ? S.bbase(nxt) : cB;
        if constexpr (GATHER) {
            if (has_next) {
                asm volatile("" ::: "memory");
#pragma unroll
                for (int i = 0; i < 2; ++i) { noff0[i] = S.arow(nxt, RA[i]) + (unsigned)CA2[i]; noff1[i] = S.arow(nxt, HALF + RA[i]) + (unsigned)CA2[i]; }
                VM_WAIT();
                asm volatile("" : "+v"(noff0[0]), "+v"(noff0[1]), "+v"(noff1[0]), "+v"(noff1[1]));
            } else {
#pragma unroll
                for (int i = 0; i < 2; ++i) { noff0[i] = coff0[i]; noff1[i] = coff1[i]; }
            }
        }
        for (int t = 0; t < nt; t += 2) {
            const bool last = (t == nt - 2);
            const char* a1 = cA + (size_t)(t + 1) * kstep;
            const char* a2 = last ? nA : cA + (size_t)(t + 2) * kstep; const char* b2 = last ? nB : cB + (size_t)(t + 2) * kstep;
            const char* a3 = a2 + kstep; const char* b3 = b2 + kstep;
            unsigned o20[2], o21[2];
#pragma unroll
            for (int i = 0; i < 2; ++i) { o20[i] = (GATHER && last) ? noff0[i] : coff0[i]; o21[i] = (GATHER && last) ? noff1[i] : coff1[i]; }
            PG8_LDB(B0, 0, 0); PG8_LDB(B1, 0, 1); PG8_SCHED; PG8_LDA(At, 0, 0); PG8_STAGE(PG8_SA(1, 1), a1, coff1);
            PG8_WAIT_V(8); PG8_WAIT_L(0); PG8_BAR; PG8_MMA(0, 0, At, B0); PG8_MMA(0, 1, At, B1); PG8_BAR; PG8_SCHED;
            PG8_LDA(At, 0, 1); PG8_STAGE(PG8_SB(0, 0), b2, voffB); PG8_STAGE(PG8_SB(0, 1), b2 + hstep, voffB); PG8_STAGE(PG8_SA(0, 0), a2, o20);
            PG8_WAIT_V(8); PG8_WAIT_L(0); PG8_BAR; PG8_MMA(1, 0, At, B0); PG8_MMA(1, 1, At, B1); PG8_BAR; PG8_SCHED;
            PG8_LDB(B0, 1, 0); PG8_LDB(B1, 1, 1); PG8_SCHED; PG8_LDA(At, 1, 0); PG8_STAGE(PG8_SA(0, 1), a2, o21);
            PG8_WAIT_V(8); PG8_WAIT_L(0); PG8_BAR; PG8_MMA(0, 0, At, B0); PG8_MMA(0, 1, At, B1); PG8_BAR; PG8_SCHED;
            PG8_LDA(At, 1, 1); PG8_STAGE(PG8_SB(1, 0), b3, voffB); PG8_STAGE(PG8_SB(1, 1), b3 + hstep, voffB); PG8_STAGE(PG8_SA(1, 0), a3, o20);
            PG8_WAIT_V(8); PG8_WAIT_L(0); PG8_BAR; PG8_MMA(1, 0, At, B0); PG8_MMA(1, 1, At, B1); PG8_BAR; PG8_SCHED;
        }
        if constexpr (ALIGN_EPI) { if (wr == 0) PG8_BAR; }
        E(acc, cur, wr, wc, fr, fq);
        if (!has_next) break;
#pragma unroll
        for (int a = 0; a < 2; ++a)
#pragma unroll
            for (int b = 0; b < 2; ++b)
#pragma unroll
                for (int m = 0; m < 4; ++m)
#pragma unroll
                    for (int n = 0; n < 2; ++n) acc[a][b][m][n] = (f32x4){0.f, 0.f, 0.f, 0.f};
        cur = nxt; cA = nA; cB = nB; ++ui;
        if constexpr (GATHER) {
#pragma unroll
            for (int i = 0; i < 2; ++i) { coff0[i] = noff0[i]; coff1[i] = noff1[i]; }
        }
        if constexpr (ALIGN_EPI) { if (wr == 1) PG8_BAR; }
    }
    PG8_WAIT_V(0);
    if constexpr (!ALIGN_EPI) { if (wr == 0) PG8_BAR; }
    PG8_BAR;
#undef PG8_SA
#undef PG8_SB
#undef PG8_STAGE
#undef PG8_LDA
#undef PG8_LDB
#undef PG8_MMA
#undef PG8_WAIT_V
#undef PG8_WAIT_L
#undef PG8_BAR
#undef PG8_SCHED
}

struct DenseSched {
    const bf16_t* A; const bf16_t* Bt; int K; int nM, nN, nwg, G, c;
    __device__ void init(const bf16_t* A_, const bf16_t* Bt_, int M, int N, int K_, int G_, int c_) { A = A_; Bt = Bt_; K = K_; nM = M / BM; nN = N / BM; nwg = nM * nN; G = G_; c = c_; }
    __device__ bool next(int i, Unit& u) const {
        const long L = (long)i * G + c; if (L >= nwg) return false;
        int wgid = (int)L; { const int q = nwg / 8, r = nwg % 8, xcd = wgid % 8, off = wgid / 8; wgid = (xcd < r ? xcd * (q + 1) : r * (q + 1) + (xcd - r) * q) + off; }
        const int WGM = 8; const int nig = WGM * nN, gid = wgid / nig, fm = gid * WGM, gsz = (nM - fm) < WGM ? (nM - fm) : WGM;
        u.pm = fm + ((wgid % nig) % gsz); u.pn = (wgid % nig) / gsz; u.e = 0; u.cnt = 1 << 30; u.rb = 0; return true;
    }
    __device__ const char* abase(const Unit& u) const { return (const char*)A + (size_t)u.pm * BM * K * 2; }
    __device__ const char* bbase(const Unit& u) const { return (const char*)Bt + (size_t)u.pn * BM * K * 2; }
    __device__ unsigned arow(const Unit&, int) const { return 0u; }
};

__device__ __forceinline__ void st_bf16x4(bf16_t* p, f32x4 v) { u32x2 w; w.x = cvt_pk_bf16(v[0], v[1]); w.y = cvt_pk_bf16(v[2], v[3]); *(u32x2*)p = w; }

struct EpiIn0F {
    static constexpr bool PERM = false;
    bf16_t* pbuf; const float2* cs;
    __device__ __forceinline__ void operator()(const f32x4 (&acc)[2][2][4][2], const Unit& u, int wr, int wc, int fr, int fq) const {
        const int kind = (u.pn < 4) ? 0 : (u.pn < 6) ? 1 : (u.pn < 8) ? 2 : 3;
#pragma unroll
        for (int ai = 0; ai < 2; ++ai)
#pragma unroll
            for (int m = 0; m < 4; ++m) {
                const int row = u.pm * BM + ai * HALF + wr * 64 + m * 16 + fr;
#pragma unroll
                for (int bj = 0; bj < 2; ++bj) {
                    const f32x4 v0 = acc[ai][bj][m][0], v1 = acc[ai][bj][m][1];
                    const int gl = 4 * bj + wc;
                    if (kind == 0) {
                        f32x4 o;
#pragma unroll
                        for (int q = 0; q < 4; ++q) o[q] = v0[q] * sigmoidf_(v1[q]);
                        st_bf16x4(pbuf + (size_t)row * 512 + 16 * (8 * u.pn + gl) + 4 * fq, o);
                    } else if (kind == 3) {
                        bf16_t* vb = pbuf + (size_t)3 * T_TOK * 512 + (size_t)row * 512 + 256 * (u.pn - 8) + 128 * bj + 32 * wc + 4 * fq;
                        st_bf16x4(vb, v0); st_bf16x4(vb + 16, v1);
                    } else {
                        const int G = 8 * (u.pn - (kind == 1 ? 4 : 6)) + gl, unit64 = G >> 1, dlo = 16 * (G & 1) + 4 * fq, pos = row & (SEQ - 1);
                        const f32x4 c01 = *(const f32x4*)(cs + pos * 32 + dlo), c23 = *(const f32x4*)(cs + pos * 32 + dlo + 2);
                        const float co[4] = {c01[0], c01[2], c23[0], c23[2]}, si[4] = {c01[1], c01[3], c23[1], c23[3]};
                        f32x4 lo, hi; const float sc = (kind == 1) ? QSCALE : 1.0f;
#pragma unroll
                        for (int q = 0; q < 4; ++q) { lo[q] = (v0[q] * co[q] - v1[q] * si[q]) * sc; hi[q] = (v1[q] * co[q] + v0[q] * si[q]) * sc; }
                        bf16_t* ob = pbuf + (size_t)kind * T_TOK * 512 + (size_t)row * 512 + 64 * unit64 + dlo;
                        st_bf16x4(ob, lo); st_bf16x4(ob + 32, hi);
                    }
                }
            }
    }
};
struct EpiPlainF {
    static constexpr bool PERM = true;
    bf16_t* O; int ldc; int scale_cols; float scale;
    __device__ __forceinline__ void operator()(const f32x4 (&acc)[2][2][4][2], const Unit& u, int wr, int wc, int fr, int fq) const {
        const float sc = (u.pn * BM < scale_cols) ? scale : 1.0f;
#pragma unroll
        for (int ai = 0; ai < 2; ++ai)
#pragma unroll
            for (int m = 0; m < 4; ++m) { bf16_t* rowp = O + (size_t)(u.pm * BM + ai * HALF + wr * 64 + m * 16 + fr) * ldc + u.pn * BM + wc * 32 + 8 * fq;
#pragma unroll
                for (int bj = 0; bj < 2; ++bj) { const f32x4 v0 = acc[ai][bj][m][0] * sc, v1 = acc[ai][bj][m][1] * sc;
                    u32x4 w; w.x = cvt_pk_bf16(v0[0], v0[1]); w.y = cvt_pk_bf16(v0[2], v0[3]); w.z = cvt_pk_bf16(v1[0], v1[1]); w.w = cvt_pk_bf16(v1[2], v1[3]);
                    *(u32x4*)(rowp + bj * HALF) = w; } }
    }
};
struct EpiResF {
    static constexpr bool PERM = true;
    bf16_t* Y; const bf16_t* X;
    __device__ __forceinline__ void operator()(const f32x4 (&acc)[2][2][4][2], const Unit& u, int wr, int wc, int fr, int fq) const {
#pragma unroll
        for (int ai = 0; ai < 2; ++ai)
#pragma unroll
            for (int m = 0; m < 4; ++m) { const size_t off = (size_t)(u.pm * BM + ai * HALF + wr * 64 + m * 16 + fr) * DM + u.pn * BM + wc * 32 + 8 * fq;
#pragma unroll
                for (int bj = 0; bj < 2; ++bj) { const f32x4 v0 = acc[ai][bj][m][0], v1 = acc[ai][bj][m][1];
                    const u32x4 xr = *(const u32x4*)(X + off + bj * HALF);
                    float r[8];
#pragma unroll
                    for (int q = 0; q < 4; ++q) { r[2 * q] = __uint_as_float(xr[q] << 16); r[2 * q + 1] = __uint_as_float(xr[q] & 0xffff0000u); }
                    u32x4 w; w.x = cvt_pk_bf16(ALPHA * r[0] + v0[0], ALPHA * r[1] + v0[1]); w.y = cvt_pk_bf16(ALPHA * r[2] + v0[2], ALPHA * r[3] + v0[3]);
                    w.z = cvt_pk_bf16(ALPHA * r[4] + v1[0], ALPHA * r[5] + v1[1]); w.w = cvt_pk_bf16(ALPHA * r[6] + v1[2], ALPHA * r[7] + v1[3]);
                    *(u32x4*)(Y + off + bj * HALF) = w; } }
    }
};

struct MoeSched {
    const bf16_t* A; const bf16_t* Bt; const int* ltok; const LAS int* tab; int K, nN, G, c; bool gather;
    __device__ bool next(int i, Unit& u) const {
        const int L = i * G + c; if (L >= tab[32] * nN) return false;
        const int mt = L / nN; int e = 0;
#pragma unroll
        for (int j = 1; j < 16; ++j) e += (tab[16 + j] <= mt) ? 1 : 0;
        u.e = e; u.pm = mt - tab[16 + e]; u.pn = L - mt * nN; u.cnt = tab[e]; u.rb = tab[33 + e]; return true;
    }
    __device__ const char* abase(const Unit& u) const { return gather ? (const char*)A : (const char*)A + (size_t)(u.rb + u.pm * BM) * K * 2; }
    __device__ const char* bbase(const Unit& u) const { return (const char*)Bt + ((size_t)u.e * 1024 + (size_t)u.pn * BM) * K * 2; }
    __device__ unsigned arow(const Unit& u, int R) const { int slot = u.pm * BM + R; slot = slot < u.cnt ? slot : u.cnt - 1; const int tk = ltok[u.e * T_TOK + slot]; return (unsigned)(tk >> 1) * (unsigned)(K * 2); }
};
struct EpiGUF {
    static constexpr bool PERM = false;
    bf16_t* H; const float* lgate;
    __device__ __forceinline__ void operator()(const f32x4 (&acc)[2][2][4][2], const Unit& u, int wr, int wc, int fr, int fq) const {
#pragma unroll
        for (int ai = 0; ai < 2; ++ai)
#pragma unroll
            for (int m = 0; m < 4; ++m) {
                const int slot = u.pm * BM + ai * HALF + wr * 64 + m * 16 + fr;
                if (slot < u.cnt) {
                    const float gt = lgate[u.e * T_TOK + slot];
                    bf16_t* hp = H + (size_t)(u.rb + slot) * DFF + 16 * (8 * u.pn + wc) + 4 * fq;
#pragma unroll
                    for (int bj = 0; bj < 2; ++bj) { const f32x4 v0 = acc[ai][bj][m][0], v1 = acc[ai][bj][m][1]; f32x4 o;
#pragma unroll
                        for (int q = 0; q < 4; ++q) o[q] = v0[q] * sigmoidf_(v0[q]) * v1[q] * gt;
                        st_bf16x4(hp + 64 * bj, o); }
                }
            }
    }
};
struct EpiDownF {
    static constexpr bool PERM = true;
    bf16_t* ys0; long ysd; const int* ltok;
    __device__ __forceinline__ void operator()(const f32x4 (&acc)[2][2][4][2], const Unit& u, int wr, int wc, int fr, int fq) const {
#pragma unroll
        for (int ai = 0; ai < 2; ++ai)
#pragma unroll
            for (int m = 0; m < 4; ++m) {
                const int slot = u.pm * BM + ai * HALF + wr * 64 + m * 16 + fr;
                if (slot < u.cnt) {
                    const int tk = ltok[u.e * T_TOK + slot];
                    bf16_t* rowp = ys0 + (long)(tk & 1) * ysd + (long)(tk >> 1) * DM + u.pn * BM + wc * 32 + 8 * fq;
#pragma unroll
                    for (int bj = 0; bj < 2; ++bj) { const f32x4 v0 = acc[ai][bj][m][0], v1 = acc[ai][bj][m][1];
                        u32x4 w; w.x = cvt_pk_bf16(v0[0], v0[1]); w.y = cvt_pk_bf16(v0[2], v0[3]); w.z = cvt_pk_bf16(v1[0], v1[1]); w.w = cvt_pk_bf16(v1[2], v1[3]);
                        *(u32x4*)(rowp + bj * HALF) = w; }
                }
            }
    }
};
}

template <class L>
__device__ __forceinline__ void transpose_item(const L& ld, int K, bf16_t* WT, int nblk, LAS float* scr, int item, int lane) {
    const int kb = item / nblk, nb = item % nblk, k0 = 64 * kb, n0 = 32 * nb;
    float tv[32];
#pragma unroll
    for (int i = 0; i < 32; ++i) tv[i] = ld(k0 + 2 * i + (lane >> 5), n0 + (lane & 31));
#pragma unroll
    for (int i = 0; i < 32; ++i) scr[(2 * i + (lane >> 5)) * 33 + (lane & 31)] = tv[i];
    LDS_WAIT(); asm volatile("" ::: "memory");
    const int c = lane & 7;
#pragma unroll
    for (int j = 0; j < 4; ++j) { const int n = (lane >> 3) + 8 * j; const LAS float* s = scr + (8 * c) * 33 + n;
        u32x4 o; o.x = cvt_pk_bf16(s[0 * 33], s[1 * 33]); o.y = cvt_pk_bf16(s[2 * 33], s[3 * 33]); o.z = cvt_pk_bf16(s[4 * 33], s[5 * 33]); o.w = cvt_pk_bf16(s[6 * 33], s[7 * 33]);
        *(u32x4*)(WT + (size_t)(n0 + n) * K + k0 + 8 * c) = o; }
    LDS_WAIT(); asm volatile("" ::: "memory");
}
struct LdPlain { const float* W; int ldw; __device__ __forceinline__ float operator()(int k, int n) const { return W[(size_t)k * ldw + n]; } };
struct LdIn0 {
    const float* W;
    __device__ __forceinline__ float operator()(int k, int n) const {
        int col;
        if (n < 1024) { const int G = n >> 5, nn = (n >> 4) & 1, i = n & 15; col = nn * 512 + 16 * G + i; }
        else if (n < 2048) { const int base = (n < 1536) ? 1024 : 1536, p = n - base, G = p >> 5, nn = (p >> 4) & 1, i = p & 15; col = base + 64 * (G >> 1) + 16 * (G & 1) + i + 32 * nn; }
        else col = n;
        return W[(size_t)k * 2560 + col];
    }
};
struct LdGU {
    const float* Wg; const float* Wu;
    __device__ __forceinline__ float operator()(int k, int n) const { const int G = n >> 5, nn = (n >> 4) & 1, i = n & 15;
        const uintptr_t d = (uintptr_t)Wu - (uintptr_t)Wg; const float* p = (const float*)((uintptr_t)Wg + (nn ? d : (uintptr_t)0)); return p[(size_t)k * DFF + 16 * G + i]; }
};
struct LdFoldB {
    const float* pw; const float* ps;
    __device__ __forceinline__ float operator()(int k, int n) const { const int g = k >> 7, d = k & 127, c = n & 127; return ((n >> 7) == g) ? pw[(g * 128 + c) * 128 + d] * ps[g * 128 + d] : 0.f; }
};

struct Frame { LAS unsigned char* lds; int tid, lane, wave, G, vcu; };

__device__ __forceinline__ void p0_prologue(const Frame& F, const Args& a) {
    LAS float* scr = (LAS float*)(F.lds + F.wave * 16384);
    const int gw = F.vcu * NWAVES + F.wave, NGW = F.G * NWAVES;
    unsigned char* ws = a.ws;
    constexpr int I_IN0 = 16 * 80, I_OUT = 16 * 32, I_GU = 16 * 32, I_D = 8 * 32, I_IN1 = 16 * 64;
    constexpr int S0 = I_IN0, S1 = S0 + I_OUT, S2 = S1 + 16 * I_GU, S3 = S2 + 16 * I_D, S4 = S3 + I_IN1, S5 = S4 + I_OUT, S6 = S5 + 16 * I_GU, S7 = S6 + 16 * I_D, S8 = S7 + 8 * 16;
    for (int it = gw; it < S8; it += NGW) {
        if (it < S0) { LdIn0 l{a.in[3]}; transpose_item(l, 1024, (bf16_t*)(ws + WT_IN0), 80, scr, it, F.lane); }
        else if (it < S1) { LdPlain l{a.in[13], 1024}; transpose_item(l, 1024, (bf16_t*)(ws + WT_OUT0), 32, scr, it - S0, F.lane); }
        else if (it < S2) { const int r = it - S1, e = r / I_GU; LdGU l{a.in[16] + (size_t)e * DM * DFF, a.in[17] + (size_t)e * DM * DFF}; transpose_item(l, 1024, (bf16_t*)(ws + WT_GU0) + (size_t)e * 1024 * 1024, 32, scr, r % I_GU, F.lane); }
        else if (it < S3) { const int r = it - S2, e = r / I_D; LdPlain l{a.in[18] + (size_t)e * DFF * DM, 1024}; transpose_item(l, 512, (bf16_t*)(ws + WT_D0) + (size_t)e * 1024 * 512, 32, scr, r % I_D, F.lane); }
        else if (it < S4) { LdPlain l{a.in[21], 2048}; transpose_item(l, 1024, (bf16_t*)(ws + WT_IN1), 64, scr, it - S3, F.lane); }
        else if (it < S5) { const int r = it - S4;
            if (r < 256) { LdPlain l{a.in[24], 1024}; transpose_item(l, 1024, (bf16_t*)(ws + WT_OUT1), 32, scr, r, F.lane); }
            else { LdPlain l{a.in[24] + (size_t)512 * DM, 1024}; transpose_item(l, 512, (bf16_t*)(ws + WT_FA), 32, scr, r - 256, F.lane); } }
        else if (it < S6) { const int r = it - S5, e = r / I_GU; LdGU l{a.in[27] + (size_t)e * DM * DFF, a.in[28] + (size_t)e * DM * DFF}; transpose_item(l, 1024, (bf16_t*)(ws + WT_GU1) + (size_t)e * 1024 * 1024, 32, scr, r % I_GU, F.lane); }
        else if (it < S7) { const int r = it - S6, e = r / I_D; LdPlain l{a.in[29] + (size_t)e * DFF * DM, 1024}; transpose_item(l, 512, (bf16_t*)(ws + WT_D1) + (size_t)e * 1024 * 512, 32, scr, r % I_D, F.lane); }
        else { LdFoldB l{a.in[22], a.in[23]}; transpose_item(l, 512, (bf16_t*)(ws + WT_FB), 16, scr, it - S7, F.lane); }
    }
    { const float* x = a.in[0]; bf16_t* xb = (bf16_t*)(ws + WS_XB); const size_t n8 = (size_t)T_TOK * DM / 8, stride = (size_t)F.G * NTHREADS;
      for (size_t i = (size_t)F.vcu * NTHREADS + F.tid; i < n8; i += stride) { const f32x4 v0 = *(const f32x4*)(x + i * 8), v1 = *(const f32x4*)(x + i * 8 + 4);
          u32x4 w; w.x = cvt_pk_bf16(v0[0], v0[1]); w.y = cvt_pk_bf16(v0[2], v0[3]); w.z = cvt_pk_bf16(v1[0], v1[1]); w.w = cvt_pk_bf16(v1[2], v1[3]); *(u32x4*)(xb + i * 8) = w; } }
    { float2* cs = (float2*)(ws + WS_ROPE);
      for (int i = F.vcu * NTHREADS + F.tid; i < SEQ * 32; i += F.G * NTHREADS) { const int pos = i >> 5, f = i & 31; const float inv = powf(10000.0f, -(float)(2 * f) / 64.0f); float s, c; sincosf((float)pos * inv, &s, &c); cs[i] = make_float2(c, s); } }
}


__device__ __forceinline__ float bflo(unsigned w) { return __uint_as_float(w << 16); }
__device__ __forceinline__ float bfhi(unsigned w) { return __uint_as_float(w & 0xffff0000u); }

__device__ __forceinline__ void ph_ln_router(const Frame& F, const bf16_t* Y, const float* g, const float* bta, const float* rw, const float* rb,
                                             bf16_t* x1b, int* ltok, float* lgate, int* cnt) {
    LAS float* rwT = (LAS float*)F.lds;
    LAS float* lgs = (LAS float*)(F.lds + 65536) + F.wave * 16;
    LAS int* lcnt = (LAS int*)(F.lds + 65536 + 1024);
    LAS int* tinfo = (LAS int*)(F.lds + 65536 + 2048);
    for (int i = F.tid; i < 16 * 1024; i += NTHREADS) { const int c = i >> 4, e = i & 15; rwT[e * 1024 + c] = rw[i]; }
    const int lane = F.lane;
    float gam[16], bet[16];
#pragma unroll
    for (int j = 0; j < 4; ++j) { const f32x4 a = *(const f32x4*)(g + 4 * lane + 256 * j), b = *(const f32x4*)(bta + 4 * lane + 256 * j);
#pragma unroll
        for (int q = 0; q < 4; ++q) { gam[4 * j + q] = a[q]; bet[4 * j + q] = b[q]; } }
    for (int tb = F.vcu; tb < T_TOK / 64; tb += F.G) {
        if (F.tid < 32) lcnt[F.tid] = 0;
        __syncthreads();
        for (int k = 0; k < 8; ++k) {
            const int tl = F.wave * 8 + k, t = tb * 64 + tl;
            float v[16], s = 0.f;
#pragma unroll
            for (int j = 0; j < 4; ++j) { const u32x2 w = *(const u32x2*)(Y + (size_t)t * DM + 4 * lane + 256 * j);
                v[4 * j] = bflo(w.x); v[4 * j + 1] = bfhi(w.x); v[4 * j + 2] = bflo(w.y); v[4 * j + 3] = bfhi(w.y); }
#pragma unroll
            for (int i = 0; i < 16; ++i) s += v[i];
            const float mean = wave_sum(s) * (1.0f / DM);
            float q2 = 0.f;
#pragma unroll
            for (int i = 0; i < 16; ++i) { v[i] -= mean; q2 += v[i] * v[i]; }
            const float rstd = rsqrtf(wave_sum(q2) * (1.0f / DM) + LN_EPS);
#pragma unroll
            for (int i = 0; i < 16; ++i) v[i] = v[i] * rstd * gam[i] + bet[i];
#pragma unroll
            for (int j = 0; j < 4; ++j) { u32x2 w; w.x = cvt_pk_bf16(v[4 * j], v[4 * j + 1]); w.y = cvt_pk_bf16(v[4 * j + 2], v[4 * j + 3]); *(u32x2*)(x1b + (size_t)t * DM + 4 * lane + 256 * j) = w; }
            float lg[16];
#pragma unroll
            for (int e = 0; e < 16; ++e) { float a = 0.f;
#pragma unroll
                for (int j = 0; j < 4; ++j) { const f32x4 w = *(const LAS f32x4*)(rwT + e * 1024 + 4 * lane + 256 * j);
                    a += v[4 * j] * w[0] + v[4 * j + 1] * w[1] + v[4 * j + 2] * w[2] + v[4 * j + 3] * w[3]; }
                lg[e] = a; }
            float r8[8], r4[4], r2[2], r1;
            { const bool up = (lane & 32) != 0;
#pragma unroll
              for (int i = 0; i < 8; ++i) { const float send = up ? lg[i] : lg[i + 8]; const float keep = up ? lg[i + 8] : lg[i]; r8[i] = keep + __shfl_xor(send, 32); } }
            { const bool up = (lane & 16) != 0;
#pragma unroll
              for (int i = 0; i < 4; ++i) { const float send = up ? r8[i] : r8[i + 4]; const float keep = up ? r8[i + 4] : r8[i]; r4[i] = keep + __shfl_xor(send, 16); } }
            { const bool up = (lane & 8) != 0;
#pragma unroll
              for (int i = 0; i < 2; ++i) { const float send = up ? r4[i] : r4[i + 2]; const float keep = up ? r4[i + 2] : r4[i]; r2[i] = keep + __shfl_xor(send, 8); } }
            { const bool up = (lane & 4) != 0; const float send = up ? r2[0] : r2[1]; const float keep = up ? r2[1] : r2[0]; r1 = keep + __shfl_xor(send, 4); }
            r1 += __shfl_xor(r1, 1); r1 += __shfl_xor(r1, 2);
            if ((lane & 3) == 0) lgs[((lane >> 5) & 1) * 8 + ((lane >> 4) & 1) * 4 + ((lane >> 3) & 1) * 2 + ((lane >> 2) & 1)] = r1;
            LDS_WAIT(); asm volatile("" ::: "memory");
            if (lane == 0) {
                float aff[16], sel[16];
#pragma unroll
                for (int e = 0; e < 16; ++e) { aff[e] = 1.0f / (1.0f + expf(-lgs[e])); sel[e] = aff[e] + rb[e]; }
                int gb = 0, bi1 = 0, bi2 = 1; float best = -INFINITY;
#pragma unroll
                for (int gi = 0; gi < 4; ++gi) {
                    int i1 = 0; float v1 = sel[gi * 4];
#pragma unroll
                    for (int kk = 1; kk < 4; ++kk) if (sel[gi * 4 + kk] > v1) { v1 = sel[gi * 4 + kk]; i1 = kk; }
                    int i2 = -1; float v2 = -INFINITY;
#pragma unroll
                    for (int kk = 0; kk < 4; ++kk) if (kk != i1 && sel[gi * 4 + kk] > v2) { v2 = sel[gi * 4 + kk]; i2 = kk; }
                    const float sc = v1 + v2;
                    if (sc > best) { best = sc; gb = gi; bi1 = i1; bi2 = i2; }
                }
                const int e0 = gb * 4 + bi1, e1 = gb * 4 + bi2;
                float a0 = 0.f, a1 = 0.f;
#pragma unroll
                for (int e = 0; e < 16; ++e) { if (e == e0) a0 = aff[e]; if (e == e1) a1 = aff[e]; }
                const float g0 = a0 / (a0 + a1), g1 = a1 / (a0 + a1);
                const int r0 = atomicAdd((int*)(lcnt + e0), 1), r1_ = atomicAdd((int*)(lcnt + e1), 1);
                LAS int* ti = tinfo + tl * 6; ti[0] = e0; ti[1] = r0; ti[2] = e1; ti[3] = r1_; ti[4] = __float_as_int(g0); ti[5] = __float_as_int(g1);
            }
            asm volatile("" ::: "memory");
        }
        __syncthreads();
        if (F.tid < 16) { const int c = lcnt[F.tid]; lcnt[16 + F.tid] = c ? atomicAdd(cnt + 64 * F.tid, c) : 0; }
        __syncthreads();
        if (F.tid < 64) { const LAS int* ti = tinfo + F.tid * 6; const int t = tb * 64 + F.tid;
            const int e0 = ti[0], s0 = lcnt[16 + e0] + ti[1], e1 = ti[2], s1 = lcnt[16 + e1] + ti[3];
            ltok[e0 * T_TOK + s0] = t * 2 + 0; lgate[e0 * T_TOK + s0] = __int_as_float(ti[4]);
            ltok[e1 * T_TOK + s1] = t * 2 + 1; lgate[e1 * T_TOK + s1] = __int_as_float(ti[5]); }
        __syncthreads();
    }
}

__device__ __forceinline__ void ph_ln_ffn(const Frame& F, const bf16_t* x1b, const bf16_t* ys0, const bf16_t* ys1, const float* g, const float* bta, bf16_t* xb_out, float* fout) {
    const int lane = F.lane, gw = F.vcu * NWAVES + F.wave, NGW = F.G * NWAVES;
    float gam[16], bet[16];
#pragma unroll
    for (int j = 0; j < 4; ++j) { const f32x4 a = *(const f32x4*)(g + 4 * lane + 256 * j), b = *(const f32x4*)(bta + 4 * lane + 256 * j);
#pragma unroll
        for (int q = 0; q < 4; ++q) { gam[4 * j + q] = a[q]; bet[4 * j + q] = b[q]; } }
    for (int t = gw; t < T_TOK; t += NGW) {
        float v[16], s = 0.f;
#pragma unroll
        for (int j = 0; j < 4; ++j) { const size_t ix = (size_t)t * DM + 4 * lane + 256 * j;
            const u32x2 a = *(const u32x2*)(x1b + ix), b = *(const u32x2*)(ys0 + ix), c = *(const u32x2*)(ys1 + ix);
            v[4 * j] = ALPHA * bflo(a.x) + bflo(b.x) + bflo(c.x); v[4 * j + 1] = ALPHA * bfhi(a.x) + bfhi(b.x) + bfhi(c.x);
            v[4 * j + 2] = ALPHA * bflo(a.y) + bflo(b.y) + bflo(c.y); v[4 * j + 3] = ALPHA * bfhi(a.y) + bfhi(b.y) + bfhi(c.y); }
#pragma unroll
        for (int i = 0; i < 16; ++i) s += v[i];
        const float mean = wave_sum(s) * (1.0f / DM);
        float q2 = 0.f;
#pragma unroll
        for (int i = 0; i < 16; ++i) { v[i] -= mean; q2 += v[i] * v[i]; }
        const float rstd = rsqrtf(wave_sum(q2) * (1.0f / DM) + LN_EPS);
#pragma unroll
        for (int i = 0; i < 16; ++i) v[i] = v[i] * rstd * gam[i] + bet[i];
#pragma unroll
        for (int j = 0; j < 4; ++j) { const size_t ix = (size_t)t * DM + 4 * lane + 256 * j;
            if (xb_out) { u32x2 w; w.x = cvt_pk_bf16(v[4 * j], v[4 * j + 1]); w.y = cvt_pk_bf16(v[4 * j + 2], v[4 * j + 3]); *(u32x2*)(xb_out + ix) = w; }
            if (fout) *(f32x4*)(fout + ix) = (f32x4){v[4 * j], v[4 * j + 1], v[4 * j + 2], v[4 * j + 3]}; }
    }
}

__device__ __forceinline__ void conv_unit(const Frame& F, int unit, const bf16_t* aglu, const float* cw, const float* cb, const float* g, const float* bta, bf16_t* mix) {
    LAS float* cv = (LAS float*)F.lds;
    const int t0 = unit * 32, cp = F.tid & 255, th = F.tid >> 8, c0 = 2 * cp;
    const int tb = t0 + th * 16, posb = tb & (SEQ - 1);
    float w0[31], w1[31];
#pragma unroll
    for (int w = 0; w < 31; ++w) { const f32x2 x = *(const f32x2*)(cw + w * 512 + c0); w0[w] = x[0]; w1[w] = x[1]; }
    const f32x2 bias = *(const f32x2*)(cb + c0);
    unsigned in[46];
#pragma unroll
    for (int r = 0; r < 46; ++r) { const int p = posb - 30 + r; in[r] = (p >= 0) ? *(const unsigned*)(aglu + (size_t)(tb - 30 + r) * 512 + c0) : 0u; }
    __syncthreads();
#pragma unroll
    for (int t = 0; t < 16; ++t) { float a0 = bias[0], a1 = bias[1];
#pragma unroll
        for (int w = 0; w < 31; ++w) { a0 += bflo(in[t + w]) * w0[w]; a1 += bfhi(in[t + w]) * w1[w]; }
        *(LAS f32x2*)(cv + (th * 16 + t) * 512 + c0) = (f32x2){a0, a1}; }
    __syncthreads();
    const int lane = F.lane;
    const f32x4 g0 = *(const f32x4*)(g + 8 * lane), g1 = *(const f32x4*)(g + 8 * lane + 4), b0 = *(const f32x4*)(bta + 8 * lane), b1 = *(const f32x4*)(bta + 8 * lane + 4);
#pragma unroll
    for (int k = 0; k < 4; ++k) { const int tl = F.wave * 4 + k;
        const f32x4 x0 = *(const LAS f32x4*)(cv + tl * 512 + 8 * lane), x1 = *(const LAS f32x4*)(cv + tl * 512 + 8 * lane + 4);
        float v[8] = {x0[0], x0[1], x0[2], x0[3], x1[0], x1[1], x1[2], x1[3]}, s = 0.f;
#pragma unroll
        for (int i = 0; i < 8; ++i) s += v[i];
        const float mean = wave_sum(s) * (1.0f / 512.0f); float q2 = 0.f;
#pragma unroll
        for (int i = 0; i < 8; ++i) { v[i] -= mean; q2 += v[i] * v[i]; }
        const float rstd = rsqrtf(wave_sum(q2) * (1.0f / 512.0f) + LN_EPS);
        const float gg[8] = {g0[0], g0[1], g0[2], g0[3], g1[0], g1[1], g1[2], g1[3]}, bb[8] = {b0[0], b0[1], b0[2], b0[3], b1[0], b1[1], b1[2], b1[3]};
#pragma unroll
        for (int i = 0; i < 8; ++i) { const float y = v[i] * rstd * gg[i] + bb[i]; v[i] = y * sigmoidf_(y); }
        u32x4 w; w.x = cvt_pk_bf16(v[0], v[1]); w.y = cvt_pk_bf16(v[2], v[3]); w.z = cvt_pk_bf16(v[4], v[5]); w.w = cvt_pk_bf16(v[6], v[7]);
        *(u32x4*)(mix + (size_t)(t0 + tl) * DM + 8 * lane) = w; }
}

__device__ __forceinline__ void pool_unit(const Frame& F, int unit, const bf16_t* P1, bf16_t* mix) {
    const int cp = F.tid & 255, th = F.tid >> 8, c0 = 2 * cp, grp = cp >> 6, win = 2 << grp;
    const int tb = unit * 64 + th * 32, posb = tb & (SEQ - 1);
    unsigned in[47];
#pragma unroll
    for (int r = 0; r < 47; ++r) { const int p = posb - 15 + r; in[r] = (p >= 0) ? *(const unsigned*)(P1 + (size_t)(tb - 15 + r) * 2048 + 1536 + c0) : 0u; }
#pragma unroll
    for (int t = 0; t < 32; ++t) { float s0 = 0.f, s1 = 0.f; const int pos = posb + t;
#pragma unroll
        for (int i = 0; i < 16; ++i) if (i < win) { s0 += bflo(in[15 + t - i]); s1 += bfhi(in[15 + t - i]); }
        const int cn = (pos + 1 < win) ? pos + 1 : win; const float ic = 1.0f / (float)cn;
        const float o0 = s0 * ic - bflo(in[15 + t]), o1 = s1 * ic - bfhi(in[15 + t]);
        *(unsigned*)(mix + (size_t)(tb + t) * DM + 512 + c0) = cvt_pk_bf16(o0, o1); }
}


namespace att {
typedef short v4i16 __attribute__((ext_vector_type(4)));
__device__ __forceinline__ int crow(int r, int hi) { return (r & 3) + 8 * (r >> 2) + 4 * hi; }
__device__ __forceinline__ v4i16 vtr(const LAS unsigned char* p) { return __builtin_amdgcn_ds_read_tr16_b64_v4i16((LAS v4i16*)p); }
__device__ __forceinline__ bf16x8 vfrag(const LAS unsigned char* p) { const v4i16 lo = vtr(p), hi = vtr(p + 512); return (bf16x8){lo[0], lo[1], lo[2], lo[3], hi[0], hi[1], hi[2], hi[3]}; }
__device__ __forceinline__ float ex2(float x) { return __builtin_amdgcn_exp2f(x); }
__device__ __forceinline__ float lg2(float x) { return __builtin_amdgcn_logf(x); }
__device__ __forceinline__ float partner32(float x, int hb) { auto rr = __builtin_amdgcn_permlane32_swap(__float_as_uint(x), __float_as_uint(x), false, false); return __uint_as_float(hb ? rr[0] : rr[1]); }
__device__ __forceinline__ bf16x8 pack8(const f32x16& p, int b) { u32x4 w; w.x = cvt_pk_bf16(p[b], p[b + 1]); w.y = cvt_pk_bf16(p[b + 2], p[b + 3]); w.z = cvt_pk_bf16(p[b + 4], p[b + 5]); w.w = cvt_pk_bf16(p[b + 6], p[b + 7]); return __builtin_bit_cast(bf16x8, w); }
#define GLDS16(src, dst) __builtin_amdgcn_global_load_lds((const unsigned*)(src), (LAS unsigned*)(dst), 16, 0, 0)

__device__ __forceinline__ void diff_unit(const Frame& F, int b, int h, int qblk, const bf16_t* Q, const bf16_t* K, const bf16_t* V, float lam, const float* sg, bf16_t* mix) {
    const int lane = F.lane, wid = F.wave, r32 = lane & 31, hb = lane >> 5, st = wid >> 2, ww = wid & 3;
    const size_t row0 = (size_t)b * SEQ;
    const int q0 = qblk * 128, qw0 = q0 + 32 * ww, qrow = qw0 + r32, nt = 2 * qblk + 2;
    bf16x8 qf[4];
    { const bf16_t* qp = Q + (row0 + qrow) * 512 + 128 * h + 64 * st + 8 * hb;
#pragma unroll
      for (int d0 = 0; d0 < 4; ++d0) qf[d0] = *(const bf16x8*)(qp + 16 * d0); }
    const bf16_t* src0; int dst0, sstep, dstep;
    if (wid < 4) { src0 = K + (row0 + lane) * 512 + 128 * h + 64 * (wid >> 1) + 32 * (wid & 1); sstep = 8; dst0 = (wid >> 1) * 8192 + (wid & 1) * 4096; dstep = 1024; }
    else { src0 = V + (row0 + 8 * (lane >> 5) + ((lane >> 2) & 7)) * 512 + 128 * h + 32 * (wid - 4) + 8 * (lane & 3); sstep = 16 * 512; dst0 = 16384 + (wid - 4) * 4096; dstep = 1024; }
#define DIFF_ISSUE(t, stg) do { const bf16_t* s_ = src0 + (size_t)(t) * 64 * 512; LAS unsigned char* d_ = F.lds + (stg) * 32768 + dst0; \
        _Pragma("unroll") for (int i_ = 0; i_ < 4; ++i_) GLDS16(s_ + (size_t)i_ * sstep, d_ + i_ * dstep); } while (0)
    f32x16 o[4];
#pragma unroll
    for (int d = 0; d < 4; ++d)
#pragma unroll
        for (int r = 0; r < 16; ++r) o[d][r] = 0.f;
    float m = -INFINITY, l = 0.f;
    const int vlane = (4 * hb + ((lane & 15) >> 2)) * 64 + ((lane >> 4) & 1) * 32 + (lane & 3) * 8;
    DIFF_ISSUE(0, 0);
    for (int t = 0; t < nt; ++t) {
        VM_WAIT(); __syncthreads();
        if (t + 1 < nt) DIFF_ISSUE(t + 1, (t + 1) & 1);
        const LAS unsigned char* sb = F.lds + (t & 1) * 32768;
        const int kv0 = 64 * t;
        if (kv0 <= qw0 + 31) {
            f32x16 p0, p1;
#pragma unroll
            for (int r = 0; r < 16; ++r) { p0[r] = 0.f; p1[r] = 0.f; }
            const LAS unsigned char* kb = sb + st * 8192 + hb * 1024 + r32 * 16;
#pragma unroll
            for (int d0 = 0; d0 < 4; ++d0) { const bf16x8 a0 = *(const LAS bf16x8*)(kb + d0 * 2048), a1 = *(const LAS bf16x8*)(kb + d0 * 2048 + 512);
                p0 = __builtin_amdgcn_mfma_f32_32x32x16_bf16(a0, qf[d0], p0, 0, 0, 0); p1 = __builtin_amdgcn_mfma_f32_32x32x16_bf16(a1, qf[d0], p1, 0, 0, 0); }
            if (kv0 + 63 > qw0) {
#pragma unroll
                for (int r = 0; r < 16; ++r) { const int kvg = kv0 + crow(r, hb); if (kvg > qrow) p0[r] = -INFINITY; if (kvg + 32 > qrow) p1[r] = -INFINITY; }
            }
            float mx = fmaxf(p0[0], p1[0]);
#pragma unroll
            for (int r = 1; r < 16; ++r) mx = fmaxf(mx, fmaxf(p0[r], p1[r]));
            mx = fmaxf(mx, partner32(mx, hb));
            const float mn = fmaxf(m, mx), alpha = ex2(m - mn); m = mn;
            float ls = 0.f;
#pragma unroll
            for (int r = 0; r < 16; ++r) { p0[r] = ex2(p0[r] - mn); p1[r] = ex2(p1[r] - mn); ls += p0[r] + p1[r]; }
            l = l * alpha + ls;
#pragma unroll
            for (int d = 0; d < 4; ++d)
#pragma unroll
                for (int r = 0; r < 16; ++r) o[d][r] *= alpha;
            const bf16x8 pf0 = pack8(p0, 0), pf1 = pack8(p0, 8), pf2 = pack8(p1, 0), pf3 = pack8(p1, 8);
            const LAS unsigned char* vb = sb + 16384 + vlane;
#pragma unroll
            for (int d = 0; d < 4; ++d) {
                o[d] = __builtin_amdgcn_mfma_f32_32x32x16_bf16(vfrag(vb + d * 4096), pf0, o[d], 0, 0, 0);
                o[d] = __builtin_amdgcn_mfma_f32_32x32x16_bf16(vfrag(vb + d * 4096 + 1024), pf1, o[d], 0, 0, 0);
                o[d] = __builtin_amdgcn_mfma_f32_32x32x16_bf16(vfrag(vb + d * 4096 + 2048), pf2, o[d], 0, 0, 0);
                o[d] = __builtin_amdgcn_mfma_f32_32x32x16_bf16(vfrag(vb + d * 4096 + 3072), pf3, o[d], 0, 0, 0);
            }
        }
    }
#undef DIFF_ISSUE
    { const float lt = l + partner32(l, hb), inv = 1.0f / lt;
#pragma unroll
      for (int d = 0; d < 4; ++d)
#pragma unroll
          for (int r = 0; r < 16; ++r) o[d][r] *= inv; }
    __syncthreads();
    LAS float* xb = (LAS float*)F.lds + ww * 4096;
    if (st == 1) {
#pragma unroll
        for (int d = 0; d < 4; ++d)
#pragma unroll
            for (int r = 0; r < 16; ++r) xb[(d * 16 + r) * 64 + lane] = o[d][r];
    }
    __syncthreads();
    if (st == 0) {
        float ss = 0.f;
#pragma unroll
        for (int d = 0; d < 4; ++d)
#pragma unroll
            for (int r = 0; r < 16; ++r) { const float v = o[d][r] - lam * xb[(d * 16 + r) * 64 + lane]; o[d][r] = v; ss += v * v; }
        ss += partner32(ss, hb);
        const float rs = rsqrtf(ss * (1.0f / 128.0f) + RMS_EPS) * (1.0f - LAM_INIT0);
        bf16_t* op = mix + (row0 + qrow) * DM + 512 + 128 * h;
#pragma unroll
        for (int d = 0; d < 4; ++d)
#pragma unroll
            for (int g4 = 0; g4 < 4; ++g4) { const int dd = 32 * d + 8 * g4 + 4 * hb; const f32x4 gv = *(const f32x4*)(sg + dd);
                pg8::st_bf16x4(op + dd, (f32x4){o[d][4 * g4] * rs * gv[0], o[d][4 * g4 + 1] * rs * gv[1], o[d][4 * g4 + 2] * rs * gv[2], o[d][4 * g4 + 3] * rs * gv[3]}); }
    }
    __syncthreads();
}

__device__ __forceinline__ void sb_unit(const Frame& F, int b, int h, int qblk, const bf16_t* P1, bf16_t* mix) {
    const int lane = F.lane, wid = F.wave, r32 = lane & 31, hb = lane >> 5;
    const size_t row0 = (size_t)b * SEQ;
    const int q0 = qblk * 256, qw0 = q0 + 32 * wid, qrow = qw0 + r32, nt = 4 * qblk + 4;
    bf16x8 qf[4];
    { const bf16_t* qp = P1 + (row0 + qrow) * 2048 + 64 * h + 8 * hb;
#pragma unroll
      for (int d0 = 0; d0 < 4; ++d0) qf[d0] = *(const bf16x8*)(qp + 16 * d0); }
    const bf16_t* src0; int dst0, sstep;
    if (wid < 4) { src0 = P1 + (row0 + lane) * 2048 + 512 + 64 * h + 16 * wid; sstep = 8; dst0 = wid * 2048; }
    else { const int w4 = wid - 4; src0 = P1 + (row0 + 32 * (w4 & 1) + 8 * (lane >> 5) + ((lane >> 2) & 7)) * 2048 + 1024 + 64 * h + 32 * (w4 >> 1) + 8 * (lane & 3); sstep = 16 * 2048; dst0 = 8192 + (w4 >> 1) * 4096 + (w4 & 1) * 2048; }
#define SB_ISSUE(t, stg) do { const bf16_t* s_ = src0 + (size_t)(t) * 64 * 2048; LAS unsigned char* d_ = F.lds + (stg) * 16384 + dst0; \
        GLDS16(s_, d_); GLDS16(s_ + sstep, d_ + 1024); } while (0)
    f32x16 o[2];
#pragma unroll
    for (int d = 0; d < 2; ++d)
#pragma unroll
        for (int r = 0; r < 16; ++r) o[d][r] = 0.f;
    float carry = 0.f;
    const int vlane = (4 * hb + ((lane & 15) >> 2)) * 64 + ((lane >> 4) & 1) * 32 + (lane & 3) * 8;
    SB_ISSUE(nt - 1, 0);
    for (int it = 0; it < nt; ++it) {
        const int t = nt - 1 - it;
        VM_WAIT(); __syncthreads();
        if (t > 0) SB_ISSUE(t - 1, (it + 1) & 1);
        const LAS unsigned char* sb = F.lds + (it & 1) * 16384;
        const int kv0 = 64 * t;
        if (kv0 <= qw0) {
            f32x16 p0, p1;
#pragma unroll
            for (int r = 0; r < 16; ++r) { p0[r] = 0.f; p1[r] = 0.f; }
            const LAS unsigned char* kb = sb + hb * 1024 + r32 * 16;
#pragma unroll
            for (int d0 = 0; d0 < 4; ++d0) { const bf16x8 a0 = *(const LAS bf16x8*)(kb + d0 * 2048), a1 = *(const LAS bf16x8*)(kb + d0 * 2048 + 512);
                p0 = __builtin_amdgcn_mfma_f32_32x32x16_bf16(a0, qf[d0], p0, 0, 0, 0); p1 = __builtin_amdgcn_mfma_f32_32x32x16_bf16(a1, qf[d0], p1, 0, 0, 0); }
            const bool diag = (kv0 + 63 >= qw0);
            f32x16 l0, l1;
#pragma unroll
            for (int r = 0; r < 16; ++r) {
                { const float z = p0[r], sp = fmaxf(z, 0.f) + lg2(1.0f + ex2(-fabsf(z))); const bool ok = !diag || (kv0 + crow(r, hb) < qrow); l0[r] = ok ? -sp : 0.f; p0[r] = ok ? z - sp : -INFINITY; }
                { const float z = p1[r], sp = fmaxf(z, 0.f) + lg2(1.0f + ex2(-fabsf(z))); const bool ok = !diag || (kv0 + 32 + crow(r, hb) < qrow); l1[r] = ok ? -sp : 0.f; p1[r] = ok ? z - sp : -INFINITY; }
            }
            float Tq[8], Tp[8], U[8], SU[8];
#pragma unroll
            for (int g4 = 0; g4 < 4; ++g4) { Tq[g4] = (l0[4 * g4] + l0[4 * g4 + 1]) + (l0[4 * g4 + 2] + l0[4 * g4 + 3]); Tq[4 + g4] = (l1[4 * g4] + l1[4 * g4 + 1]) + (l1[4 * g4 + 2] + l1[4 * g4 + 3]); }
#pragma unroll
            for (int k = 0; k < 8; ++k) { Tp[k] = partner32(Tq[k], hb); U[k] = Tq[k] + Tp[k]; }
            SU[7] = 0.f;
#pragma unroll
            for (int k = 6; k >= 0; --k) SU[k] = SU[k + 1] + U[k + 1];
#pragma unroll
            for (int k = 0; k < 8; ++k) {
                const float base = carry + SU[k] + (hb ? 0.f : Tp[k]);
                if (k < 4) { const int q = 4 * k; const float s3 = base, s2 = s3 + l0[q + 3], s1 = s2 + l0[q + 2], s0 = s1 + l0[q + 1];
                    p0[q] = ex2(p0[q] + s0); p0[q + 1] = ex2(p0[q + 1] + s1); p0[q + 2] = ex2(p0[q + 2] + s2); p0[q + 3] = ex2(p0[q + 3] + s3); }
                else { const int q = 4 * (k - 4); const float s3 = base, s2 = s3 + l1[q + 3], s1 = s2 + l1[q + 2], s0 = s1 + l1[q + 1];
                    p1[q] = ex2(p1[q] + s0); p1[q + 1] = ex2(p1[q + 1] + s1); p1[q + 2] = ex2(p1[q + 2] + s2); p1[q + 3] = ex2(p1[q + 3] + s3); }
            }
            carry += SU[0] + U[0];
            const bf16x8 pf0 = pack8(p0, 0), pf1 = pack8(p0, 8), pf2 = pack8(p1, 0), pf3 = pack8(p1, 8);
            const LAS unsigned char* vb = sb + 8192 + vlane;
#pragma unroll
            for (int d = 0; d < 2; ++d) {
                o[d] = __builtin_amdgcn_mfma_f32_32x32x16_bf16(vfrag(vb + d * 4096), pf0, o[d], 0, 0, 0);
                o[d] = __builtin_amdgcn_mfma_f32_32x32x16_bf16(vfrag(vb + d * 4096 + 1024), pf1, o[d], 0, 0, 0);
                o[d] = __builtin_amdgcn_mfma_f32_32x32x16_bf16(vfrag(vb + d * 4096 + 2048), pf2, o[d], 0, 0, 0);
                o[d] = __builtin_amdgcn_mfma_f32_32x32x16_bf16(vfrag(vb + d * 4096 + 3072), pf3, o[d], 0, 0, 0);
            }
        }
    }
#undef SB_ISSUE
    bf16_t* op = mix + (row0 + qrow) * DM + 64 * h;
#pragma unroll
    for (int d = 0; d < 2; ++d)
#pragma unroll
        for (int g4 = 0; g4 < 4; ++g4) pg8::st_bf16x4(op + 32 * d + 8 * g4 + 4 * hb, (f32x4){o[d][4 * g4], o[d][4 * g4 + 1], o[d][4 * g4 + 2], o[d][4 * g4 + 3]});
    __syncthreads();
}
#undef GLDS16
}

enum Phase { PH_PRO = 0, PH_IN0 = 1, PH_MIX0 = 2, PH_OUT0 = 3, PH_LN0 = 4, PH_GU0 = 5, PH_DN0 = 6, PH_FFN0 = 7, PH_IN1 = 8, PH_MIX1 = 9, PH_OUT1 = 10, PH_LN1 = 11, PH_GU1 = 12, PH_DN1 = 13, PH_FFN1 = 14, PH_N = 15 };


#define XB_TMO      128
#define XB_XCNT(j)  (256  + 64 * (j))
#define XB_XSUB(j)  (1280 + 64 * (j))
#define XB_XGEN(j)  (2304 + 64 * (j))
#define XB_TOP      3328
#define XB_TOPGEN   3392
#define XCD_BAR_WORDS 3456
#define XB_SPIN_CAP (1u << 18)
constexpr int CW_BAR = 4096;
__device__ __forceinline__ unsigned xb_ld(unsigned* p)              { return __hip_atomic_load(p, __ATOMIC_RELAXED, __HIP_MEMORY_SCOPE_AGENT); }
__device__ __forceinline__ unsigned xb_add(unsigned* p, unsigned v) { return __hip_atomic_fetch_add(p, v, __ATOMIC_RELAXED, __HIP_MEMORY_SCOPE_AGENT); }
__device__ __forceinline__ unsigned xb_xcc_id() { return (unsigned)__builtin_amdgcn_s_getreg((3 << 11) | 20) & 0xFu; }
#define XB_SPIN(cond, bar) do { unsigned _sp = 0; while (cond) { __builtin_amdgcn_s_sleep(1); \
    if ((++_sp & 255u) == 0u) { if (xb_ld(&(bar)[XB_TMO])) break; if (_sp > XB_SPIN_CAP) { atomicAdd(&(bar)[XB_TMO], 1u); break; } } } } while (0)
struct XcdBarrier { unsigned* bar; unsigned x; volatile LAS unsigned* st; };
__device__ __forceinline__ XcdBarrier xcd_barrier_post(unsigned* bar, volatile LAS unsigned* st) {
    XcdBarrier b; b.bar = bar; b.x = xb_xcc_id(); b.st = st;
    if (threadIdx.x == 0) (void)xb_add(&bar[XB_XCNT(b.x)], 1u);
    return b;
}
__device__ __forceinline__ void xcd_barrier_complete(unsigned* bar, unsigned x, unsigned& nloc, unsigned& nx) {
    const unsigned G = gridDim.x * gridDim.y * gridDim.z;
    unsigned sum, cnt, mine, sp = 0u;
    for (;;) {
        sum = 0u; cnt = 0u; mine = 0u;
#pragma unroll
        for (unsigned j = 0; j < 16; ++j) { const unsigned c = xb_ld(&bar[XB_XCNT(j)]); sum += c; cnt += (c > 0u) ? 1u : 0u; mine = (j == x) ? c : mine; }
        if (sum == G) break;
        __builtin_amdgcn_s_sleep(1);
        if ((++sp & 255u) == 0u) { if (xb_ld(&bar[XB_TMO])) break; if (sp > XB_SPIN_CAP) { atomicAdd(&bar[XB_TMO], 1u); break; } }
    }
    nloc = mine > 0u ? mine : 1u; nx = cnt > 0u ? cnt : 1u;
}
__device__ __forceinline__ void xcd_barrier(const XcdBarrier& b) {
    asm volatile("s_waitcnt vmcnt(0)" ::: "memory");
    __syncthreads();
    if (threadIdx.x == 0) {
        unsigned* bar = b.bar;
        __builtin_amdgcn_s_waitcnt(0);
        unsigned nloc = b.st[0], nx = b.st[1];
        if (nloc == 0u) { xcd_barrier_complete(bar, b.x, nloc, nx); b.st[0] = nloc; b.st[1] = nx; }
        const unsigned old = xb_add(&bar[XB_XSUB(b.x)], 1u);
        const unsigned gen = old / nloc;
        if (old + 1u == (gen + 1u) * nloc) {
            __builtin_amdgcn_fence(__ATOMIC_RELEASE, "agent");
            asm volatile("s_waitcnt vmcnt(0)" ::: "memory");
            const unsigned og = xb_add(&bar[XB_TOP], 1u);
            const unsigned tg = og / nx;
            if (og + 1u == (tg + 1u) * nx) xb_add(&bar[XB_TOPGEN], 1u);
            else XB_SPIN(xb_ld(&bar[XB_TOPGEN]) == tg, bar);
            __builtin_amdgcn_fence(__ATOMIC_ACQUIRE, "agent");
            xb_add(&bar[XB_XGEN(b.x)], 1u);
            asm volatile("s_waitcnt vmcnt(0)" ::: "memory");
        } else {
            XB_SPIN(xb_ld(&bar[XB_XGEN(b.x)]) == gen, bar);
            __builtin_amdgcn_fence(__ATOMIC_ACQUIRE, "agent");
            asm volatile("s_waitcnt vmcnt(0)" ::: "memory");
        }
    }
    __syncthreads();
}

__global__ void __launch_bounds__(NTHREADS, 2) mk_fwd(Args args) {
    extern __shared__ __attribute__((aligned(16))) unsigned char lds_raw[];
    Frame F; F.lds = (LAS unsigned char*)lds_raw; F.tid = threadIdx.x; F.lane = F.tid & 63; F.wave = __builtin_amdgcn_readfirstlane(F.tid >> 6);
    F.G = gridDim.x; { const int bx = blockIdx.x; F.vcu = (F.G % 8 == 0) ? (bx % 8) * (F.G / 8) + bx / 8 : bx; }
    unsigned char* ws = args.ws;
    const int lo = args.ph_lo, hi = args.ph_hi;
    if (F.tid < 128) ((LAS unsigned*)(F.lds + MISC_OFF))[F.tid] = 0u;
    __syncthreads();
    XcdBarrier bar; bar.bar = (unsigned*)(ws + WS_CTL) + CW_BAR; bar.x = 0; bar.st = nullptr;
    if (hi - lo > 1) bar = xcd_barrier_post((unsigned*)(ws + WS_CTL) + CW_BAR, (volatile LAS unsigned*)(F.lds + MISC_OFF + 256));
#define IN(k) (lo <= (k) && (k) < hi)
#define SEAM(k) do { if (IN(k) && IN((k) + 1)) xcd_barrier(bar); } while (0)
    bf16_t* XB = (bf16_t*)(ws + WS_XB); bf16_t* PBUF = (bf16_t*)(ws + WS_PBUF); bf16_t* MIX = (bf16_t*)(ws + WS_MIX); bf16_t* X1B = (bf16_t*)(ws + WS_X1B);
    int* ltok = (int*)(ws + WS_LTOK); float* lgate = (float*)(ws + WS_LGATE); int* cntw = (int*)(ws + WS_CTL) + CW_CNT;
    LAS int* tab = (LAS int*)(F.lds + MISC_OFF);
#define MOE_TABLE(LAYER) do { if (F.tid == 0) { const int* cg = cntw + 1024 * (LAYER); int p = 0, r = 0; \
        for (int e = 0; e < 16; ++e) { const int c = cg[64 * e]; tab[e] = c; tab[16 + e] = p; tab[33 + e] = r; p += (c + 255) >> 8; r += c; } tab[32] = p; tab[49] = r; } \
        __syncthreads(); } while (0)

    if (IN(PH_PRO)) { p0_prologue(F, args); }
    SEAM(PH_PRO);
    if (IN(PH_IN0)) {
        pg8::DenseSched S; S.init(XB, (const bf16_t*)(ws + WT_IN0), T_TOK, 2560, 1024, F.G, (int)blockIdx.x);
        pg8::EpiIn0F E{PBUF, (const float2*)(ws + WS_ROPE)};
        pg8::gemm_phase<pg8::EpiIn0F, pg8::DenseSched, false, true>(F.lds, 1024, S, E);
        { pg8::DenseSched S2; S2.init((const bf16_t*)(ws + WT_FA), (const bf16_t*)(ws + WT_FB), 1024, 512, 512, 8, (int)blockIdx.x - (F.G - 8));
          if ((int)blockIdx.x >= F.G - 8) { pg8::EpiPlainF E2{(bf16_t*)(ws + WT_OUT1) + 512, 1024, 0, 1.0f};
              pg8::gemm_phase<pg8::EpiPlainF, pg8::DenseSched, false, true>(F.lds, 512, S2, E2); } }
    }
    SEAM(PH_IN0);
    if (IN(PH_MIX0)) {
        for (int u = F.vcu; u < T_TOK / 32; u += F.G) conv_unit(F, u, PBUF, args.in[4], args.in[5], args.in[6], args.in[7], MIX);
        __syncthreads();
        const float d1 = wave_sum(args.in[8][F.lane] * args.in[9][F.lane]), d2 = wave_sum(args.in[10][F.lane] * args.in[11][F.lane]);
        const float lam = expf(d1) - expf(d2) + LAM_INIT0;
        for (int p = F.vcu; p < 256; p += F.G) { const int bh = p >> 3, sidx = p & 7;
            att::diff_unit(F, bh >> 2, bh & 3, 15 - sidx, PBUF + (size_t)T_TOK * 512, PBUF + (size_t)2 * T_TOK * 512, PBUF + (size_t)3 * T_TOK * 512, lam, args.in[12], MIX);
            att::diff_unit(F, bh >> 2, bh & 3, sidx, PBUF + (size_t)T_TOK * 512, PBUF + (size_t)2 * T_TOK * 512, PBUF + (size_t)3 * T_TOK * 512, lam, args.in[12], MIX); }
    }
    SEAM(PH_MIX0);
    if (IN(PH_OUT0)) {
        pg8::DenseSched S; S.init(MIX, (const bf16_t*)(ws + WT_OUT0), T_TOK, 1024, 1024, F.G, (int)blockIdx.x);
        pg8::EpiResF E{PBUF, XB};
        pg8::gemm_phase<pg8::EpiResF, pg8::DenseSched, false, true>(F.lds, 1024, S, E);
    }
    SEAM(PH_OUT0);
    if (IN(PH_LN0)) ph_ln_router(F, PBUF, args.in[14], args.in[15], args.in[1], args.in[2], X1B, ltok, lgate, cntw);
    SEAM(PH_LN0);
    if (IN(PH_GU0) || IN(PH_DN0)) MOE_TABLE(0);
    if (IN(PH_GU0)) { pg8::MoeSched S{X1B, (const bf16_t*)(ws + WT_GU0), ltok, tab, 1024, 4, F.G, (int)blockIdx.x, true};
        pg8::EpiGUF E{PBUF, lgate};
        pg8::gemm_phase<pg8::EpiGUF, pg8::MoeSched, true, true>(F.lds, 1024, S, E); }
    SEAM(PH_GU0);
    if (IN(PH_DN0)) { pg8::MoeSched S{PBUF, (const bf16_t*)(ws + WT_D0), ltok, tab, 512, 4, F.G, (int)blockIdx.x, false};
        pg8::EpiDownF E{MIX, (long)(XB - MIX), ltok};
        pg8::gemm_phase<pg8::EpiDownF, pg8::MoeSched, false, true>(F.lds, 512, S, E); }
    SEAM(PH_DN0);
    if (IN(PH_FFN0)) ph_ln_ffn(F, X1B, MIX, XB, args.in[19], args.in[20], XB, nullptr);
    SEAM(PH_FFN0);
    if (IN(PH_IN1)) {
        pg8::DenseSched S; S.init(XB, (const bf16_t*)(ws + WT_IN1), T_TOK, 2048, 1024, F.G, (int)blockIdx.x);
        pg8::EpiPlainF E{PBUF, 2048, 512, QSCALE};
        pg8::gemm_phase<pg8::EpiPlainF, pg8::DenseSched, false, true>(F.lds, 1024, S, E);
    }
    SEAM(PH_IN1);
    if (IN(PH_MIX1)) {
        for (int u = F.vcu; u < T_TOK / 64; u += F.G) pool_unit(F, u, PBUF, MIX);
        for (int p = F.vcu; p < 256; p += F.G) { const int bh = p >> 2, sidx = p & 3;
            att::sb_unit(F, bh >> 3, bh & 7, 7 - sidx, PBUF, MIX);
            att::sb_unit(F, bh >> 3, bh & 7, sidx, PBUF, MIX); }
    }
    SEAM(PH_MIX1);
    if (IN(PH_OUT1)) {
        pg8::DenseSched S; S.init(MIX, (const bf16_t*)(ws + WT_OUT1), T_TOK, 1024, 1024, F.G, (int)blockIdx.x);
        pg8::EpiResF E{PBUF, XB};
        pg8::gemm_phase<pg8::EpiResF, pg8::DenseSched, false, true>(F.lds, 1024, S, E);
    }
    SEAM(PH_OUT1);
    if (IN(PH_LN1)) ph_ln_router(F, PBUF, args.in[25], args.in[26], args.in[1], args.in[2], X1B, ltok, lgate, cntw + 1024);
    SEAM(PH_LN1);
    if (IN(PH_GU1) || IN(PH_DN1)) MOE_TABLE(1);
    if (IN(PH_GU1)) { pg8::MoeSched S{X1B, (const bf16_t*)(ws + WT_GU1), ltok, tab, 1024, 4, F.G, (int)blockIdx.x, true};
        pg8::EpiGUF E{PBUF, lgate};
        pg8::gemm_phase<pg8::EpiGUF, pg8::MoeSched, true, true>(F.lds, 1024, S, E); }
    SEAM(PH_GU1);
    if (IN(PH_DN1)) { pg8::MoeSched S{PBUF, (const bf16_t*)(ws + WT_D1), ltok, tab, 512, 4, F.G, (int)blockIdx.x, false};
        pg8::EpiDownF E{MIX, (long)(XB - MIX), ltok};
        pg8::gemm_phase<pg8::EpiDownF, pg8::MoeSched, false, true>(F.lds, 512, S, E); }
    SEAM(PH_DN1);
    if (IN(PH_FFN1)) ph_ln_ffn(F, X1B, MIX, XB, args.in[30], args.in[31], nullptr, args.out);
#undef IN
#undef SEAM
#undef MOE_TABLE
}

extern "C" void kernel_launch(void* const* d_in, const int* in_sizes, int n_in, void* d_out, int out_size, void* d_ws, size_t ws_size, hipStream_t stream) {
    if (n_in != 32 || ws_size < WS_END || out_size != T_TOK * DM) { fprintf(stderr, "kernel_launch: unexpected problem (n_in %d ws %zu out %d)\n", n_in, ws_size, out_size); return; }
    static int grid = 0;
    if (grid == 0) {
        int dev = 0, cus = 0;
        if (hipGetDevice(&dev) != hipSuccess || hipDeviceGetAttribute(&cus, hipDeviceAttributeMultiprocessorCount, dev) != hipSuccess) { grid = -1; return; }
        if (hipFuncSetAttribute((const void*)mk_fwd, hipFuncAttributeMaxDynamicSharedMemorySize, LDS_BYTES) != hipSuccess) { fprintf(stderr, "hipFuncSetAttribute failed\n"); grid = -1; return; }
        grid = cus;
    }
    if (grid < 0) return;
    const float* const* in = (const float* const*)d_in;
    unsigned char* ws = (unsigned char*)d_ws;
    (void)hipMemsetAsync(ws + WS_CTL, 0, 1 * MiB, stream);
    int* ctl = (int*)(ws + WS_CTL);
    float2* rope = (float2*)(ws + WS_ROPE);
    int4* topk = (int4*)(ws + WS_TOPK);
    int* ltok = (int*)(ws + WS_LTOK); float* lgate = (float*)(ws + WS_LGATE);
    float* wfold = (float*)(ws + WS_WFOLD);
    bf16_t* XB = (bf16_t*)(ws + WS_XB); bf16_t* PBUF = (bf16_t*)(ws + WS_PBUF); bf16_t* MIX = (bf16_t*)(ws + WS_MIX); bf16_t* X1B = (bf16_t*)(ws + WS_X1B);
    bf16_t* Y = PBUF; bf16_t* YS0 = MIX; bf16_t* YS1 = XB;
    Args a{};
    for (int i = 0; i < 32; ++i) a.in[i] = in[i];
    a.out = (float*)d_out; a.ws = ws;
    auto phases = [&](int lo, int hi) { a.ph_lo = lo; a.ph_hi = hi; hipLaunchKernelGGL(mk_fwd, dim3(grid), dim3(NTHREADS), LDS_BYTES, stream, a); };
    (void)rope; (void)wfold; (void)topk; (void)ltok; (void)lgate; (void)ctl; (void)Y; (void)YS0; (void)YS1; (void)X1B; (void)MIX; (void)PBUF; (void)XB;

    phases(PH_PRO, PH_N);
#ifdef PROBE_LIST
    { static const int pl[] = {PROBE_LIST}; for (int r = 0; r < PROBE_REP; ++r) for (int k : pl) phases(k, k + 1); }
#endif
}
```

```cpp
#include <hip/hip_runtime.h>
#include <cstdint>
#include <cstdio>

typedef unsigned short bf16_t;

constexpr int T_TOK = 16384, DM = 1024, SEQ = 2048, NB = 8;
constexpr int NE = 16, DFF = 512;
constexpr float ALPHA = 1.41421356237f;
constexpr float LN_EPS = 1e-5f, RMS_EPS = 1e-5f;
constexpr float LOG2E = 1.4426950408889634f;
constexpr float QSCALE = 0.125f * LOG2E;
constexpr float LAM_INIT0 = 0.2f;

constexpr size_t MiB = 1u << 20;
constexpr size_t WS_CTL = 0;
constexpr size_t WS_ROPE = 1 * MiB;
constexpr size_t WS_TOPK = 2 * MiB;
constexpr size_t WS_LTOK = 3 * MiB;
constexpr size_t WS_LGATE = 4 * MiB;
constexpr size_t WS_WFOLD = 243 * MiB;
constexpr size_t WS_WT = 6 * MiB;
constexpr size_t WS_XB = 115 * MiB;
constexpr size_t WS_PBUF = 147 * MiB;
constexpr size_t WS_MIX = 211 * MiB;
constexpr size_t WS_X1B = 243 * MiB;
constexpr size_t WS_END = 275 * MiB;

constexpr int CW_CNT = 8192;

__device__ __forceinline__ float bf2f(bf16_t v) { return __uint_as_float(((unsigned)v) << 16); }
__device__ __forceinline__ bf16_t f2bf(float f) { unsigned u = __float_as_uint(f); return (bf16_t)((u + 0x7fffu + ((u >> 16) & 1u)) >> 16); }
__device__ __forceinline__ float sigmoidf_(float x) { return 1.0f / (1.0f + __expf(-x)); }
__device__ __forceinline__ float wave_sum(float v) {
#pragma unroll
    for (int o = 1; o < 64; o <<= 1) v += __shfl_xor(v, o);
    return v;
}

__global__ void k_cvt_bf16(const float* __restrict__ x, bf16_t* __restrict__ o, size_t n) {
    size_t i = (size_t)blockIdx.x * blockDim.x + threadIdx.x;
    if (i < n) o[i] = f2bf(x[i]);
}
__global__ void k_rope_table(float2* cs) {
    int i = blockIdx.x * blockDim.x + threadIdx.x; if (i >= SEQ * 32) return;
    int pos = i / 32, f = i % 32;
    float inv = powf(10000.0f, -(float)(2 * f) / 64.0f);
    float ang = (float)pos * inv;
    float s, c; sincosf(ang, &s, &c);
    cs[i] = make_float2(c, s);
}

template <bool PAIR, class Epi>
__global__ __launch_bounds__(256) void k_gemm_naive(const bf16_t* __restrict__ A, int lda, const float* __restrict__ W, int ldw, int K, Epi epi) {
    __shared__ float As[16][65];
    __shared__ float Wa[16][65];
    __shared__ float Wb[16][65];
    const int tid = threadIdx.x, tx = tid & 15, ty = tid >> 4;
    const int m0 = blockIdx.y * 64, j0 = blockIdx.x * 64;
    float accA[4][4], accB[4][4];
#pragma unroll
    for (int i = 0; i < 4; ++i)
#pragma unroll
        for (int j = 0; j < 4; ++j) { accA[i][j] = 0.f; accB[i][j] = 0.f; }
    for (int k0 = 0; k0 < K; k0 += 16) {
        for (int i = tid; i < 1024; i += 256) { int r = i >> 4, kk = i & 15; As[kk][r] = bf2f(A[(size_t)(m0 + r) * lda + k0 + kk]); }
        for (int i = tid; i < 1024; i += 256) { int kk = i >> 6, jj = i & 63;
            Wa[kk][jj] = W[(size_t)(k0 + kk) * ldw + epi.colA(j0 + jj)];
            if (PAIR) Wb[kk][jj] = W[(size_t)(k0 + kk) * ldw + epi.colB(j0 + jj)]; }
        __syncthreads();
#pragma unroll
        for (int kk = 0; kk < 16; ++kk) {
            float a[4], b[4], c[4];
#pragma unroll
            for (int i = 0; i < 4; ++i) a[i] = As[kk][ty * 4 + i];
#pragma unroll
            for (int j = 0; j < 4; ++j) { b[j] = Wa[kk][tx * 4 + j]; c[j] = PAIR ? Wb[kk][tx * 4 + j] : 0.f; }
#pragma unroll
            for (int i = 0; i < 4; ++i)
#pragma unroll
                for (int j = 0; j < 4; ++j) { accA[i][j] += a[i] * b[j]; if (PAIR) accB[i][j] += a[i] * c[j]; }
        }
        __syncthreads();
    }
#pragma unroll
    for (int i = 0; i < 4; ++i)
#pragma unroll
        for (int j = 0; j < 4; ++j) epi.store(m0 + ty * 4 + i, j0 + tx * 4 + j, accA[i][j], accB[i][j]);
}

struct EpiIn0 {
    bf16_t* pbuf; const float2* cs;
    __device__ int colA(int j) const { if (j < 512) return j; if (j < 1024) return 1024 + (j - 512); if (j < 1536) return 1536 + (j - 1024); return 2048 + (j - 1536); }
    __device__ int colB(int j) const { if (j < 512) return 512 + j; if (j < 1024) return 1024 + ((j - 512) ^ 32); if (j < 1536) return 1536 + ((j - 1024) ^ 32); return 2048 + (j - 1536); }
    __device__ void store(int m, int j, float a, float b) const {
        const int reg = j >> 9, jj = j & 511; float o;
        if (reg == 0) o = a * sigmoidf_(b);
        else if (reg == 3) o = a;
        else { const int d = jj & 63, pos = m & (SEQ - 1); const float2 c = cs[pos * 32 + (d & 31)];
            o = (d < 32) ? a * c.x - b * c.y : a * c.x + b * c.y; if (reg == 1) o *= QSCALE; }
        pbuf[(size_t)reg * T_TOK * 512 + (size_t)m * 512 + jj] = f2bf(o);
    }
};
struct EpiIn1 {
    bf16_t* p1;
    __device__ int colA(int j) const { return j; }
    __device__ int colB(int j) const { return j; }
    __device__ void store(int m, int j, float a, float) const { p1[(size_t)m * 2048 + j] = f2bf(j < 512 ? a * QSCALE : a); }
};
struct EpiOut {
    bf16_t* y; const bf16_t* xb;
    __device__ int colA(int j) const { return j; }
    __device__ int colB(int j) const { return j; }
    __device__ void store(int m, int j, float a, float) const { y[(size_t)m * DM + j] = f2bf(ALPHA * bf2f(xb[(size_t)m * DM + j]) + a); }
};

__global__ __launch_bounds__(512) void k_conv_naive(const bf16_t* __restrict__ aglu, const float* __restrict__ cw, const float* __restrict__ cb,
                                                   const float* __restrict__ g, const float* __restrict__ b, bf16_t* __restrict__ mix) {
    __shared__ float red[16];
    const int t = blockIdx.x, c = threadIdx.x, pos = t & (SEQ - 1);
    float acc = cb[c];
    for (int w = 0; w < 31; ++w) { const int p = pos - 30 + w; if (p >= 0) acc += bf2f(aglu[(size_t)(t - 30 + w) * 512 + c]) * cw[w * 512 + c]; }
    float s = wave_sum(acc);
    if ((c & 63) == 0) red[c >> 6] = s;
    __syncthreads();
    float tot = 0.f;
    for (int i = 0; i < 8; ++i) tot += red[i];
    const float mean = tot * (1.0f / 512.0f), d = acc - mean;
    float q = wave_sum(d * d);
    if ((c & 63) == 0) red[8 + (c >> 6)] = q;
    __syncthreads();
    float tq = 0.f;
    for (int i = 0; i < 8; ++i) tq += red[8 + i];
    const float rstd = rsqrtf(tq * (1.0f / 512.0f) + LN_EPS);
    const float y = d * rstd * g[c] + b[c];
    mix[(size_t)t * DM + c] = f2bf(y * sigmoidf_(y));
}

__global__ __launch_bounds__(256) void k_diffattn_naive(const bf16_t* __restrict__ Q, const bf16_t* __restrict__ Kt, const bf16_t* __restrict__ V, bf16_t* __restrict__ obuf) {
    __shared__ float Qs[32][65];
    __shared__ float Ks[32][65];
    __shared__ float Vs[32][129];
    __shared__ float Ps[32][33];
    const int tid = threadIdx.x, tx = tid & 7, ty = tid >> 3;
    const int qb = blockIdx.x, bh = blockIdx.y, st = blockIdx.z, b = bh >> 2, h = bh & 3;
    const size_t row0 = (size_t)b * SEQ;
    const int q0 = qb * 32, colqk = h * 128 + st * 64, colv = h * 128;
    for (int i = tid; i < 32 * 64; i += 256) { int r = i >> 6, d = i & 63; Qs[r][d] = bf2f(Q[(row0 + q0 + r) * 512 + colqk + d]); }
    float m = -INFINITY, l = 0.f, o[16];
#pragma unroll
    for (int c = 0; c < 16; ++c) o[c] = 0.f;
    const int qrow = q0 + ty;
    for (int j0 = 0; j0 <= q0; j0 += 32) {
        __syncthreads();
        for (int i = tid; i < 32 * 64; i += 256) { int r = i >> 6, d = i & 63; Ks[r][d] = bf2f(Kt[(row0 + j0 + r) * 512 + colqk + d]); }
        for (int i = tid; i < 32 * 128; i += 256) { int r = i >> 7, d = i & 127; Vs[r][d] = bf2f(V[(row0 + j0 + r) * 512 + colv + d]); }
        __syncthreads();
        float s[4], mx = -INFINITY;
#pragma unroll
        for (int i = 0; i < 4; ++i) { const int kk = tx + 8 * i; float a = 0.f;
            for (int d = 0; d < 64; ++d) a += Qs[ty][d] * Ks[kk][d];
            if (j0 + kk > qrow) a = -INFINITY; s[i] = a; mx = fmaxf(mx, a); }
        mx = fmaxf(mx, __shfl_xor(mx, 1)); mx = fmaxf(mx, __shfl_xor(mx, 2)); mx = fmaxf(mx, __shfl_xor(mx, 4));
        const float mn = fmaxf(m, mx), alpha = exp2f(m - mn);
        float ps = 0.f;
#pragma unroll
        for (int i = 0; i < 4; ++i) { const float p = exp2f(s[i] - mn); ps += p; Ps[ty][tx + 8 * i] = p; }
        ps += __shfl_xor(ps, 1); ps += __shfl_xor(ps, 2); ps += __shfl_xor(ps, 4);
        l = l * alpha + ps; m = mn;
        __syncthreads();
#pragma unroll
        for (int c = 0; c < 16; ++c) { const int d = tx + 8 * c; float a = o[c] * alpha;
            for (int kk = 0; kk < 32; ++kk) a += Ps[ty][kk] * Vs[kk][d];
            o[c] = a; }
    }
    const float il = 1.0f / l;
#pragma unroll
    for (int c = 0; c < 16; ++c) obuf[(size_t)st * T_TOK * 512 + (row0 + qrow) * 512 + colv + tx + 8 * c] = f2bf(o[c] * il);
}
__global__ __launch_bounds__(512) void k_diffcombine_naive(const bf16_t* __restrict__ obuf, const float* lq1, const float* lk1, const float* lq2, const float* lk2,
                                                          const float* __restrict__ sg, bf16_t* __restrict__ mix) {
    const int t = blockIdx.x, c = threadIdx.x, lane = c & 63;
    const float d1 = wave_sum(lq1[lane] * lk1[lane]), d2 = wave_sum(lq2[lane] * lk2[lane]);
    const float lam = expf(d1) - expf(d2) + LAM_INIT0;
    const float o = bf2f(obuf[(size_t)t * 512 + c]) - lam * bf2f(obuf[(size_t)T_TOK * 512 + (size_t)t * 512 + c]);
    float ss = wave_sum(o * o);
    __shared__ float red[8];
    if (lane == 0) red[c >> 6] = ss;
    __syncthreads();
    const int hw = (c >> 7) * 2;
    const float tot = red[hw] + red[hw + 1];
    const float r = rsqrtf(tot * (1.0f / 128.0f) + RMS_EPS);
    mix[(size_t)t * DM + 512 + c] = f2bf(o * r * sg[c & 127] * (1.0f - LAM_INIT0));
}

__global__ __launch_bounds__(256) void k_sbattn_naive(const bf16_t* __restrict__ P1, bf16_t* __restrict__ mix) {
    __shared__ float Qs[32][65];
    __shared__ float Ks[32][65];
    __shared__ float Vs[32][65];
    __shared__ float Ps[32][33];
    const int tid = threadIdx.x, tx = tid & 7, ty = tid >> 3;
    const int qb = blockIdx.x, bh = blockIdx.y, b = bh >> 3, h = bh & 7;
    const size_t row0 = (size_t)b * SEQ;
    const int q0 = qb * 32;
    for (int i = tid; i < 32 * 64; i += 256) { int r = i >> 6, d = i & 63; Qs[r][d] = bf2f(P1[(row0 + q0 + r) * 2048 + h * 64 + d]); }
    float carry = 0.f, o[8];
#pragma unroll
    for (int c = 0; c < 8; ++c) o[c] = 0.f;
    const int qrow = q0 + ty;
    for (int j0 = q0; j0 >= 0; j0 -= 32) {
        __syncthreads();
        for (int i = tid; i < 32 * 64; i += 256) { int r = i >> 6, d = i & 63;
            Ks[r][d] = bf2f(P1[(row0 + j0 + r) * 2048 + 512 + h * 64 + d]); Vs[r][d] = bf2f(P1[(row0 + j0 + r) * 2048 + 1024 + h * 64 + d]); }
        __syncthreads();
        float ls[4], lb[4]; bool ok[4]; float tsum = 0.f;
#pragma unroll
        for (int i = 0; i < 4; ++i) { const int kk = tx * 4 + i; float z = 0.f;
            for (int d = 0; d < 64; ++d) z += Qs[ty][d] * Ks[kk][d];
            ok[i] = (j0 + kk) < qrow;
            const float sp = fmaxf(z, 0.f) + log2f(1.0f + exp2f(-fabsf(z)));
            ls[i] = ok[i] ? -sp : 0.f; lb[i] = z - sp; tsum += ls[i]; }
        float R = tsum;
        { float v = __shfl_down(R, 1); if (tx + 1 < 8) R += v; }
        { float v = __shfl_down(R, 2); if (tx + 2 < 8) R += v; }
        { float v = __shfl_down(R, 4); if (tx + 4 < 8) R += v; }
        const float tile_total = __shfl(R, (tid & 63) & ~7);
        float suf = carry + (R - tsum);
#pragma unroll
        for (int i = 3; i >= 0; --i) { const float a = ok[i] ? exp2f(lb[i] + suf) : 0.f; Ps[ty][tx * 4 + i] = a; suf += ls[i]; }
        carry += tile_total;
        __syncthreads();
#pragma unroll
        for (int c = 0; c < 8; ++c) { const int d = tx + 8 * c; float a = o[c];
            for (int kk = 0; kk < 32; ++kk) a += Ps[ty][kk] * Vs[kk][d];
            o[c] = a; }
    }
#pragma unroll
    for (int c = 0; c < 8; ++c) mix[(row0 + qrow) * DM + h * 64 + tx + 8 * c] = f2bf(o[c]);
}

__global__ void k_pool_naive(const bf16_t* __restrict__ P1, bf16_t* __restrict__ mix) {
    const size_t i = (size_t)blockIdx.x * blockDim.x + threadIdx.x; if (i >= (size_t)T_TOK * 512) return;
    const int t = (int)(i >> 9), c = (int)(i & 511), g = c >> 7, win = 2 << g, pos = t & (SEQ - 1);
    const int cnt = (pos + 1 < win) ? pos + 1 : win;
    float s = 0.f;
    for (int k = 0; k < cnt; ++k) s += bf2f(P1[(size_t)(t - k) * 2048 + 1536 + c]);
    const float u = bf2f(P1[(size_t)t * 2048 + 1536 + c]);
    mix[(size_t)t * DM + 512 + c] = f2bf(s / (float)cnt - u);
}
__global__ void k_fold_naive(const float* __restrict__ op, const float* __restrict__ pw, const float* __restrict__ ps, float* __restrict__ wf) {
    const int i = blockIdx.x * blockDim.x + threadIdx.x; if (i >= 1024 * 1024) return;
    const int r = i >> 10, n = i & 1023;
    if (r < 512) { wf[i] = op[i]; return; }
    const int g = (r - 512) >> 7, c = (r - 512) & 127;
    float a = 0.f;
    for (int d = 0; d < 128; ++d) a += pw[(g * 128 + c) * 128 + d] * ps[g * 128 + d] * op[(size_t)(512 + g * 128 + d) * 1024 + n];
    wf[i] = a;
}

__global__ __launch_bounds__(256) void k_ln_router_naive(const bf16_t* __restrict__ Y, const float* __restrict__ g, const float* __restrict__ bta,
                                                         const float* __restrict__ rw, const float* __restrict__ rb, bf16_t* __restrict__ x1b,
                                                         int4* __restrict__ topk, int* __restrict__ ltok, float* __restrict__ lgate, int* __restrict__ cnt) {
    const int lane = threadIdx.x & 63, t = blockIdx.x * 4 + (threadIdx.x >> 6);
    float v[16], s = 0.f;
#pragma unroll
    for (int i = 0; i < 16; ++i) { v[i] = bf2f(Y[(size_t)t * DM + lane + 64 * i]); s += v[i]; }
    const float mean = wave_sum(s) * (1.0f / DM);
    float q = 0.f;
#pragma unroll
    for (int i = 0; i < 16; ++i) { v[i] -= mean; q += v[i] * v[i]; }
    const float rstd = rsqrtf(wave_sum(q) * (1.0f / DM) + LN_EPS);
    float lg[16];
#pragma unroll
    for (int e = 0; e < 16; ++e) lg[e] = 0.f;
#pragma unroll
    for (int i = 0; i < 16; ++i) { const int c = lane + 64 * i; const float y = v[i] * rstd * g[c] + bta[c];
        x1b[(size_t)t * DM + c] = f2bf(y);
#pragma unroll
        for (int e = 0; e < 16; ++e) lg[e] += y * rw[c * 16 + e]; }
#pragma unroll
    for (int e = 0; e < 16; ++e) lg[e] = wave_sum(lg[e]);
    if (lane == 0) {
        float aff[16], sel[16];
#pragma unroll
        for (int e = 0; e < 16; ++e) { aff[e] = 1.0f / (1.0f + expf(-lg[e])); sel[e] = aff[e] + rb[e]; }
        int gb = 0, bi1 = 0, bi2 = 1; float best = -INFINITY;
#pragma unroll
        for (int gi = 0; gi < 4; ++gi) {
            int i1 = 0; float v1 = sel[gi * 4];
#pragma unroll
            for (int k = 1; k < 4; ++k) if (sel[gi * 4 + k] > v1) { v1 = sel[gi * 4 + k]; i1 = k; }
            int i2 = -1; float v2 = -INFINITY;
#pragma unroll
            for (int k = 0; k < 4; ++k) if (k != i1 && sel[gi * 4 + k] > v2) { v2 = sel[gi * 4 + k]; i2 = k; }
            const float sc = v1 + v2;
            if (sc > best) { best = sc; gb = gi; bi1 = i1; bi2 = i2; }
        }
        const int e0 = gb * 4 + bi1, e1 = gb * 4 + bi2;
        float a0 = 0.f, a1 = 0.f;
#pragma unroll
        for (int e = 0; e < 16; ++e) { if (e == e0) a0 = aff[e]; if (e == e1) a1 = aff[e]; }
        const float g0 = a0 / (a0 + a1), g1 = a1 / (a0 + a1);
        topk[t] = make_int4(e0, e1, __float_as_int(g0), __float_as_int(g1));
        const int s0 = atomicAdd(&cnt[e0], 1); ltok[e0 * T_TOK + s0] = t * 2 + 0; lgate[e0 * T_TOK + s0] = g0;
        const int s1 = atomicAdd(&cnt[e1], 1); ltok[e1 * T_TOK + s1] = t * 2 + 1; lgate[e1 * T_TOK + s1] = g1;
    }
}

__global__ __launch_bounds__(256) void k_moe_naive(const bf16_t* __restrict__ x1b, const int4* __restrict__ topk, const float* __restrict__ wg, const float* __restrict__ wu,
                                                   const float* __restrict__ wd, bf16_t* __restrict__ ys0, bf16_t* __restrict__ ys1) {
    __shared__ float xs[DM];
    __shared__ float hs[DFF];
    const int t = blockIdx.x, tid = threadIdx.x;
    for (int i = tid; i < DM; i += 256) xs[i] = bf2f(x1b[(size_t)t * DM + i]);
    const int4 tk = topk[t];
    for (int k = 0; k < 2; ++k) {
        const int e = k ? tk.y : tk.x; const float gate = __int_as_float(k ? tk.w : tk.z);
        __syncthreads();
        const float* G = wg + (size_t)e * DM * DFF; const float* U = wu + (size_t)e * DM * DFF;
        float g0 = 0.f, g1 = 0.f, u0 = 0.f, u1 = 0.f;
        for (int d = 0; d < DM; ++d) { const float x = xs[d]; g0 += x * G[(size_t)d * DFF + tid]; g1 += x * G[(size_t)d * DFF + tid + 256];
            u0 += x * U[(size_t)d * DFF + tid]; u1 += x * U[(size_t)d * DFF + tid + 256]; }
        hs[tid] = g0 * sigmoidf_(g0) * u0 * gate; hs[tid + 256] = g1 * sigmoidf_(g1) * u1 * gate;
        __syncthreads();
        const float* Dw = wd + (size_t)e * DFF * DM;
        float y[4] = {0.f, 0.f, 0.f, 0.f};
        for (int f = 0; f < DFF; ++f) { const float hv = hs[f];
#pragma unroll
            for (int i = 0; i < 4; ++i) y[i] += hv * Dw[(size_t)f * DM + tid + 256 * i]; }
        bf16_t* ys = k ? ys1 : ys0;
#pragma unroll
        for (int i = 0; i < 4; ++i) ys[(size_t)t * DM + tid + 256 * i] = f2bf(y[i]);
    }
}

__global__ __launch_bounds__(256) void k_ln_ffn_naive(const bf16_t* x1b, const bf16_t* ys0, const bf16_t* ys1, const float* __restrict__ g,
                                                      const float* __restrict__ bta, bf16_t* xb_out, float* fout) {
    const int lane = threadIdx.x & 63, t = blockIdx.x * 4 + (threadIdx.x >> 6);
    float v[16], s = 0.f;
#pragma unroll
    for (int i = 0; i < 16; ++i) { const size_t ix = (size_t)t * DM + lane + 64 * i; v[i] = ALPHA * bf2f(x1b[ix]) + bf2f(ys0[ix]) + bf2f(ys1[ix]); s += v[i]; }
    const float mean = wave_sum(s) * (1.0f / DM);
    float q = 0.f;
#pragma unroll
    for (int i = 0; i < 16; ++i) { v[i] -= mean; q += v[i] * v[i]; }
    const float rstd = rsqrtf(wave_sum(q) * (1.0f / DM) + LN_EPS);
#pragma unroll
    for (int i = 0; i < 16; ++i) { const int c = lane + 64 * i; const float y = v[i] * rstd * g[c] + bta[c]; const size_t ix = (size_t)t * DM + c;
        if (xb_out) xb_out[ix] = f2bf(y); if (fout) fout[ix] = y; }
}


#define LAS __attribute__((address_space(3)))
#define GAS __attribute__((address_space(1)))
typedef short bf16x8 __attribute__((ext_vector_type(8)));
typedef float f32x4 __attribute__((ext_vector_type(4)));
typedef float f32x2 __attribute__((ext_vector_type(2)));
typedef float f32x16 __attribute__((ext_vector_type(16)));
typedef unsigned u32x4 __attribute__((ext_vector_type(4)));
typedef unsigned u32x2 __attribute__((ext_vector_type(2)));
constexpr int NWAVES = 8, NTHREADS = 512;
constexpr int LDS_BYTES = 147456;
constexpr int RING_BYTES = 131072;
constexpr int MISC_OFF = RING_BYTES;

constexpr size_t WT_IN0 = WS_WT;
constexpr size_t WT_OUT0 = WT_IN0 + (size_t)2560 * 1024 * 2;
constexpr size_t WT_GU0 = WT_OUT0 + (size_t)1024 * 1024 * 2;
constexpr size_t WT_D0 = WT_GU0 + (size_t)16 * 1024 * 1024 * 2;
constexpr size_t WT_IN1 = WT_D0 + (size_t)16 * 1024 * 512 * 2;
constexpr size_t WT_OUT1 = WT_IN1 + (size_t)2048 * 1024 * 2;
constexpr size_t WT_GU1 = WT_OUT1 + (size_t)1024 * 1024 * 2;
constexpr size_t WT_D1 = WT_GU1 + (size_t)16 * 1024 * 1024 * 2;
constexpr size_t WT_END = WT_D1 + (size_t)16 * 1024 * 512 * 2;
constexpr size_t WT_FA = 5 * MiB;
constexpr size_t WT_FB = 2 * MiB;
static_assert(WT_END <= WS_XB, "weight copies overflow their region");

__device__ __forceinline__ unsigned cvt_pk_bf16(float lo, float hi) { unsigned r; asm volatile("v_cvt_pk_bf16_f32 %0, %1, %2" : "=v"(r) : "v"(lo), "v"(hi)); return r; }
#define LDS_WAIT() asm volatile("s_waitcnt lgkmcnt(0)" ::: "memory")
#define VM_WAIT() asm volatile("s_waitcnt vmcnt(0)" ::: "memory")

struct Args {
    const float* in[32]; float* out; unsigned char* ws; int ph_lo, ph_hi;
};

namespace pg8 {
constexpr int BM = 256, BK = 64, HALF = 128, HTB = HALF * BK * 2, STAGE_BYTES = 8 * HTB;
static_assert(STAGE_BYTES <= RING_BYTES, "stage buffers");
__host__ __device__ __forceinline__ int lds_byte(int r, int c) { const int st = (r >> 4) * 2 + (c >> 5), rr = r & 15, cc = c & 31, ob = rr * 64 + cc * 2; return st * 1024 + (ob ^ (((ob >> 9) & 1) << 5)); }
__host__ __device__ __forceinline__ void stage_rc(int b, int& R, int& C) { const int st = b / 1024, sb = b % 1024, swz = sb ^ (((sb >> 9) & 1) << 5); R = (st >> 1) * 16 + swz / 64; C = (st & 1) * 32 + (swz % 64) / 2; }
__host__ __device__ __forceinline__ int perm32(int rho) { const int n = rho >> 4, i = rho & 15; return 8 * (i >> 2) + 4 * n + (i & 3); }

struct Unit { int pm, pn, e, cnt, rb; };

template <class Epi, class Sched, bool GATHER, bool ALIGN_EPI>
__device__ __forceinline__ void gemm_phase(LAS unsigned char* lds, const int K, const Sched& S, const Epi& E) {
    const int tid = threadIdx.x, wid = __builtin_amdgcn_readfirstlane(tid >> 6), lane = tid & 63, wr = wid >> 2, wc = wid & 3, fr = lane & 15, fq = lane >> 4;
    const int nt = K / BK;
    unsigned voffB[2], coff0[2], coff1[2], noff0[2], noff1[2]; int RA[2], CA2[2];
#pragma unroll
    for (int i = 0; i < 2; ++i) { int R, C; stage_rc(tid * 16 + i * 8192, R, C); const int Rb = Epi::PERM ? ((R & ~31) + perm32(R & 31)) : R;
        voffB[i] = (unsigned)(Rb * K + C) * 2u; RA[i] = R; CA2[i] = C * 2;
        coff0[i] = (unsigned)(R * K + C) * 2u; coff1[i] = coff0[i] + (unsigned)(HALF * K * 2); noff0[i] = coff0[i]; noff1[i] = coff1[i]; }
    const size_t kstep = (size_t)(BK * 2);
    const size_t hstep = (size_t)HALF * K * 2;
    const unsigned ldsw = (unsigned)wid * 1024u;
    const int aoff = lds_byte(wr * 64 + fr, fq * 8), boff = lds_byte(wc * 32 + fr, fq * 8);
#define PG8_SA(b, h) (((b) * 2 + (h)) * HTB)
#define PG8_SB(b, h) ((4 + (b) * 2 + (h)) * HTB)
#define PG8_STAGE(bufoff, gbase, voff) do { _Pragma("unroll") for (int _i = 0; _i < 2; ++_i) \
        __builtin_amdgcn_global_load_lds((const unsigned*)((const char*)(gbase) + (voff)[_i]), (LAS unsigned*)(lds + (bufoff) + ldsw + _i * 8192), 16, 0, 0); } while (0)
#define PG8_LDA(dst, b, h) do { _Pragma("unroll") for (int m = 0; m < 4; ++m) _Pragma("unroll") for (int k = 0; k < 2; ++k) dst[m][k] = *(const LAS bf16x8*)(lds + PG8_SA(b, h) + aoff + m * 2048 + k * 1024); } while (0)
#define PG8_LDB(dst, b, h) do { _Pragma("unroll") for (int n = 0; n < 2; ++n) _Pragma("unroll") for (int k = 0; k < 2; ++k) dst[n][k] = *(const LAS bf16x8*)(lds + PG8_SB(b, h) + boff + n * 2048 + k * 1024); } while (0)
#define PG8_MMA(ai, bj, At, Bt) do { __builtin_amdgcn_s_setprio(1); _Pragma("unroll") for (int m = 0; m < 4; ++m) _Pragma("unroll") for (int n = 0; n < 2; ++n) _Pragma("unroll") for (int k = 0; k < 2; ++k) \
        acc[ai][bj][m][n] = __builtin_amdgcn_mfma_f32_16x16x32_bf16(Bt[n][k], At[m][k], acc[ai][bj][m][n], 0, 0, 0); __builtin_amdgcn_s_setprio(0); } while (0)
#define PG8_WAIT_V(n) asm volatile("s_waitcnt vmcnt(" #n ")" ::: "memory")
#define PG8_WAIT_L(n) asm volatile("s_waitcnt lgkmcnt(" #n ")" ::: "memory")
#define PG8_BAR __builtin_amdgcn_s_barrier()
#define PG8_SCHED __builtin_amdgcn_sched_barrier(0)
    Unit cur, nxt; int ui = 0;
    if (!S.next(0, cur)) return;
    if constexpr (GATHER) {
        asm volatile("" ::: "memory");
#pragma unroll
        for (int i = 0; i < 2; ++i) { coff0[i] = S.arow(cur, RA[i]) + (unsigned)CA2[i]; coff1[i] = S.arow(cur, HALF + RA[i]) + (unsigned)CA2[i]; }
        VM_WAIT();
        asm volatile("" : "+v"(coff0[0]), "+v"(coff0[1]), "+v"(coff1[0]), "+v"(coff1[1]));
    }
    f32x4 acc[2][2][4][2];
#pragma unroll
    for (int a = 0; a < 2; ++a)
#pragma unroll
        for (int b = 0; b < 2; ++b)
#pragma unroll
            for (int m = 0; m < 4; ++m)
#pragma unroll
                for (int n = 0; n < 2; ++n) acc[a][b][m][n] = (f32x4){0.f, 0.f, 0.f, 0.f};
    bf16x8 At[4][2], B0[2][2], B1[2][2];
    const char* cA = S.abase(cur); const char* cB = S.bbase(cur);
    PG8_STAGE(PG8_SB(0, 0), cB, voffB); PG8_STAGE(PG8_SB(0, 1), cB + hstep, voffB); PG8_STAGE(PG8_SA(0, 0), cA, coff0); PG8_STAGE(PG8_SA(0, 1), cA, coff1);
    if (wr == 1) PG8_BAR;
    PG8_WAIT_V(2); PG8_BAR;
    PG8_STAGE(PG8_SB(1, 0), cB + kstep, voffB); PG8_STAGE(PG8_SA(1, 0), cA + kstep, coff0); PG8_STAGE(PG8_SB(1, 1), cB + hstep + kstep, voffB);
    PG8_WAIT_V(6); PG8_BAR;
    for (;;) {
        const bool has_next = S.next(ui + 1, nxt);
        const char* nA = has_next ? S.abase(nxt) : cA; const char* nB = has_next ? S.bbase(nxt) : cB;
        if constexpr (GATHER) {
            if (has_next) {
                asm volatile("" ::: "memory");
#pragma unroll
                for (int i = 0; i < 2; ++i) { noff0[i] = S.arow(nxt, RA[i]) + (unsigned)CA2[i]; noff1[i] = S.arow(nxt, HALF + RA[i]) + (unsigned)CA2[i]; }
                VM_WAIT();
                asm volatile("" : "+v"(noff0[0]), "+v"(noff0[1]), "+v"(noff1[0]), "+v"(noff1[1]));
            } else {
#pragma unroll
                for (int i = 0; i < 2; ++i) { noff0[i] = coff0[i]; noff1[i] = coff1[i]; }
            }
        }
        for (int t = 0; t < nt; t += 2) {
            const bool last = (t == nt - 2);
            const char* a1 = cA + (size_t)(t + 1) * kstep;
            const char* a2 = last ? nA : cA + (size_t)(t + 2) * kstep; const char* b2 = last ? nB : cB + (size_t)(t + 2) * kstep;
            const char* a3 = a2 + kstep; const char* b3 = b2 + kstep;
            unsigned o20[2], o21[2];
#pragma unroll
            for (int i = 0; i < 2; ++i) { o20[i] = (GATHER && last) ? noff0[i] : coff0[i]; o21[i] = (GATHER && last) ? noff1[i] : coff1[i]; }
            PG8_LDB(B0, 0, 0); PG8_LDB(B1, 0, 1); PG8_SCHED; PG8_LDA(At, 0, 0); PG8_STAGE(PG8_SA(1, 1), a1, coff1);
            PG8_WAIT_V(8); PG8_WAIT_L(0); PG8_BAR; PG8_MMA(0, 0, At, B0); PG8_MMA(0, 1, At, B1); PG8_BAR; PG8_SCHED;
            PG8_LDA(At, 0, 1); PG8_STAGE(PG8_SB(0, 0), b2, voffB); PG8_STAGE(PG8_SB(0, 1), b2 + hstep, voffB); PG8_STAGE(PG8_SA(0, 0), a2, o20);
            PG8_WAIT_V(8); PG8_WAIT_L(0); PG8_BAR; PG8_MMA(1, 0, At, B0); PG8_MMA(1, 1, At, B1); PG8_BAR; PG8_SCHED;
            PG8_LDB(B0, 1, 0); PG8_LDB(B1, 1, 1); PG8_SCHED; PG8_LDA(At, 1, 0); PG8_STAGE(PG8_SA(0, 1), a2, o21);
            PG8_WAIT_V(8); PG8_WAIT_L(0); PG8_BAR; PG8_MMA(0, 0, At, B0); PG8_MMA(0, 1, At, B1); PG8_BAR; PG8_SCHED;
            PG8_LDA(At, 1, 1); PG8_STAGE(PG8_SB(1, 0), b3, voffB); PG8_STAGE(PG8_SB(1, 1), b3 + hstep, voffB); PG8_STAGE(PG8_SA(1, 0), a3, o20);
            PG8_WAIT_V(8); PG8_WAIT_L(0); PG8_BAR; PG8_MMA(1, 0, At, B0); PG8_MMA(1, 1, At, B1); PG8_BAR; PG8_SCHED;
        }
        if constexpr (ALIGN_EPI) { if (wr == 0) PG8_BAR; }
        E(acc, cur, wr, wc, fr, fq);
        if (!has_next) break;
#pragma unroll
        for (int a = 0; a < 2; ++a)
#pragma unroll
            for (int b = 0; b < 2; ++b)
#pragma unroll
                for (int m = 0; m < 4; ++m)
#pragma unroll
                    for (int n = 0; n < 2; ++n) acc[a][b][m][n] = (f32x4){0.f, 0.f, 0.f, 0.f};
        cur = nxt; cA = nA; cB = nB; ++ui;
        if constexpr (GATHER) {
#pragma unroll
            for (int i = 0; i < 2; ++i) { coff0[i] = noff0[i]; coff1[i] = noff1[i]; }
        }
        if constexpr (ALIGN_EPI) { if (wr == 1) PG8_BAR; }
    }
    PG8_WAIT_V(0);
    if constexpr (!ALIGN_EPI) { if (wr == 0) PG8_BAR; }
    PG8_BAR;
#undef PG8_SA
#undef PG8_SB
#undef PG8_STAGE
#undef PG8_LDA
#undef PG8_LDB
#undef PG8_MMA
#undef PG8_WAIT_V
#undef PG8_WAIT_L
#undef PG8_BAR
#undef PG8_SCHED
}

struct DenseSched {
    const bf16_t* A; const bf16_t* Bt; int K; int nM, nN, nwg, G, c;
    __device__ void init(const bf16_t* A_, const bf16_t* Bt_, int M, int N, int K_, int G_, int c_) { A = A_; Bt = Bt_; K = K_; nM = M / BM; nN = N / BM; nwg = nM * nN; G = G_; c = c_; }
    __device__ bool next(int i, Unit& u) const {
        const long L = (long)i * G + c; if (L >= nwg) return false;
        int wgid = (int)L; { const int q = nwg / 8, r = nwg % 8, xcd = wgid % 8, off = wgid / 8; wgid = (xcd < r ? xcd * (q + 1) : r * (q + 1) + (xcd - r) * q) + off; }
        const int WGM = 8; const int nig = WGM * nN, gid = wgid / nig, fm = gid * WGM, gsz = (nM - fm) < WGM ? (nM - fm) : WGM;
        u.pm = fm + ((wgid % nig) % gsz); u.pn = (wgid % nig) / gsz; u.e = 0; u.cnt = 1 << 30; u.rb = 0; return true;
    }
    __device__ const char* abase(const Unit& u) const { return (const char*)A + (size_t)u.pm * BM * K * 2; }
    __device__ const char* bbase(const Unit& u) const { return (const char*)Bt + (size_t)u.pn * BM * K * 2; }
    __device__ unsigned arow(const Unit&, int) const { return 0u; }
};

__device__ __forceinline__ void st_bf16x4(bf16_t* p, f32x4 v) { u32x2 w; w.x = cvt_pk_bf16(v[0], v[1]); w.y = cvt_pk_bf16(v[2], v[3]); *(u32x2*)p = w; }

struct EpiIn0F {
    static constexpr bool PERM = false;
    bf16_t* pbuf; const float2* cs;
    __device__ __forceinline__ void operator()(const f32x4 (&acc)[2][2][4][2], const Unit& u, int wr, int wc, int fr, int fq) const {
        const int kind = (u.pn < 4) ? 0 : (u.pn < 6) ? 1 : (u.pn < 8) ? 2 : 3;
#pragma unroll
        for (int ai = 0; ai < 2; ++ai)
#pragma unroll
            for (int m = 0; m < 4; ++m) {
                const int row = u.pm * BM + ai * HALF + wr * 64 + m * 16 + fr;
#pragma unroll
                for (int bj = 0; bj < 2; ++bj) {
                    const f32x4 v0 = acc[ai][bj][m][0], v1 = acc[ai][bj][m][1];
                    const int gl = 4 * bj + wc;
                    if (kind == 0) {
                        f32x4 o;
#pragma unroll
                        for (int q = 0; q < 4; ++q) o[q] = v0[q] * sigmoidf_(v1[q]);
                        st_bf16x4(pbuf + (size_t)row * 512 + 16 * (8 * u.pn + gl) + 4 * fq, o);
                    } else if (kind == 3) {
                        bf16_t* vb = pbuf + (size_t)3 * T_TOK * 512 + (size_t)row * 512 + 256 * (u.pn - 8) + 128 * bj + 32 * wc + 4 * fq;
                        st_bf16x4(vb, v0); st_bf16x4(vb + 16, v1);
                    } else {
                        const int G = 8 * (u.pn - (kind == 1 ? 4 : 6)) + gl, unit64 = G >> 1, dlo = 16 * (G & 1) + 4 * fq, pos = row & (SEQ - 1);
                        const f32x4 c01 = *(const f32x4*)(cs + pos * 32 + dlo), c23 = *(const f32x4*)(cs + pos * 32 + dlo + 2);
                        const float co[4] = {c01[0], c01[2], c23[0], c23[2]}, si[4] = {c01[1], c01[3], c23[1], c23[3]};
                        f32x4 lo, hi; const float sc = (kind == 1) ? QSCALE : 1.0f;
#pragma unroll
                        for (int q = 0; q < 4; ++q) { lo[q] = (v0[q] * co[q] - v1[q] * si[q]) * sc; hi[q] = (v1[q] * co[q] + v0[q] * si[q]) * sc; }
                        bf16_t* ob = pbuf + (size_t)kind * T_TOK * 512 + (size_t)row * 512 + 64 * unit64 + dlo;
                        st_bf16x4(ob, lo); st_bf16x4(ob + 32, hi);
                    }
                }
            }
    }
};
struct EpiPlainF {
    static constexpr bool PERM = true;
    bf16_t* O; int ldc; int scale_cols; float scale;
    __device__ __forceinline__ void operator()(const f32x4 (&acc)[2][2][4][2], const Unit& u, int wr, int wc, int fr, int fq) const {
        const float sc = (u.pn * BM < scale_cols) ? scale : 1.0f;
#pragma unroll
        for (int ai = 0; ai < 2; ++ai)
#pragma unroll
            for (int m = 0; m < 4; ++m) { bf16_t* rowp = O + (size_t)(u.pm * BM + ai * HALF + wr * 64 + m * 16 + fr) * ldc + u.pn * BM + wc * 32 + 8 * fq;
#pragma unroll
                for (int bj = 0; bj < 2; ++bj) { const f32x4 v0 = acc[ai][bj][m][0] * sc, v1 = acc[ai][bj][m][1] * sc;
                    u32x4 w; w.x = cvt_pk_bf16(v0[0], v0[1]); w.y = cvt_pk_bf16(v0[2], v0[3]); w.z = cvt_pk_bf16(v1[0], v1[1]); w.w = cvt_pk_bf16(v1[2], v1[3]);
                    *(u32x4*)(rowp + bj * HALF) = w; } }
    }
};
struct EpiResF {
    static constexpr bool PERM = true;
    bf16_t* Y; const bf16_t* X;
    __device__ __forceinline__ void operator()(const f32x4 (&acc)[2][2][4][2], const Unit& u, int wr, int wc, int fr, int fq) const {
#pragma unroll
        for (int ai = 0; ai < 2; ++ai)
#pragma unroll
            for (int m = 0; m < 4; ++m) { const size_t off = (size_t)(u.pm * BM + ai * HALF + wr * 64 + m * 16 + fr) * DM + u.pn * BM + wc * 32 + 8 * fq;
#pragma unroll
                for (int bj = 0; bj < 2; ++bj) { const f32x4 v0 = acc[ai][bj][m][0], v1 = acc[ai][bj][m][1];
                    const u32x4 xr = *(const u32x4*)(X + off + bj * HALF);
                    float r[8];
#pragma unroll
                    for (int q = 0; q < 4; ++q) { r[2 * q] = __uint_as_float(xr[q] << 16); r[2 * q + 1] = __uint_as_float(xr[q] & 0xffff0000u); }
                    u32x4 w; w.x = cvt_pk_bf16(ALPHA * r[0] + v0[0], ALPHA * r[1] + v0[1]); w.y = cvt_pk_bf16(ALPHA * r[2] + v0[2], ALPHA * r[3] + v0[3]);
                    w.z = cvt_pk_bf16(ALPHA * r[4] + v1[0], ALPHA * r[5] + v1[1]); w.w = cvt_pk_bf16(ALPHA * r[6] + v1[2], ALPHA * r[7] + v1[3]);
                    *(u32x4*)(Y + off + bj * HALF) = w; } }
    }
};

struct MoeSched {
    const bf16_t* A; const bf16_t* Bt; const int* ltok; const LAS int* tab; int K, nN, G, c; bool gather;
    __device__ bool next(int i, Unit& u) const {
        const int L = i * G + c; if (L >= tab[32] * nN) return false;
        const int mt = L / nN; int e = 0;
#pragma unroll
        for (int j = 1; j < 16; ++j) e += (tab[16 + j] <= mt) ? 1 : 0;
        u.e = e; u.pm = mt - tab[16 + e]; u.pn = L - mt * nN; u.cnt = tab[e]; u.rb = tab[33 + e]; return true;
    }
    __device__ const char* abase(const Unit& u) const { return gather ? (const char*)A : (const char*)A + (size_t)(u.rb + u.pm * BM) * K * 2; }
    __device__ const char* bbase(const Unit& u) const { return (const char*)Bt + ((size_t)u.e * 1024 + (size_t)u.pn * BM) * K * 2; }
    __device__ unsigned arow(const Unit& u, int R) const { int slot = u.pm * BM + R; slot = slot < u.cnt ? slot : u.cnt - 1; const int tk = ltok[u.e * T_TOK + slot]; return (unsigned)(tk >> 1) * (unsigned)(K * 2); }
};
struct EpiGUF {
    static constexpr bool PERM = false;
    bf16_t* H; const float* lgate;
    __device__ __forceinline__ void operator()(const f32x4 (&acc)[2][2][4][2], const Unit& u, int wr, int wc, int fr, int fq) const {
#pragma unroll
        for (int ai = 0; ai < 2; ++ai)
#pragma unroll
            for (int m = 0; m < 4; ++m) {
                const int slot = u.pm * BM + ai * HALF + wr * 64 + m * 16 + fr;
                if (slot < u.cnt) {
                    const float gt = lgate[u.e * T_TOK + slot];
                    bf16_t* hp = H + (size_t)(u.rb + slot) * DFF + 16 * (8 * u.pn + wc) + 4 * fq;
#pragma unroll
                    for (int bj = 0; bj < 2; ++bj) { const f32x4 v0 = acc[ai][bj][m][0], v1 = acc[ai][bj][m][1]; f32x4 o;
#pragma unroll
                        for (int q = 0; q < 4; ++q) o[q] = v0[q] * sigmoidf_(v0[q]) * v1[q] * gt;
                        st_bf16x4(hp + 64 * bj, o); }
                }
            }
    }
};
struct EpiDownF {
    static constexpr bool PERM = true;
    bf16_t* ys0; long ysd; const int* ltok;
    __device__ __forceinline__ void operator()(const f32x4 (&acc)[2][2][4][2], const Unit& u, int wr, int wc, int fr, int fq) const {
#pragma unroll
        for (int ai = 0; ai < 2; ++ai)
#pragma unroll
            for (int m = 0; m < 4; ++m) {
                const int slot = u.pm * BM + ai * HALF + wr * 64 + m * 16 + fr;
                if (slot < u.cnt) {
                    const int tk = ltok[u.e * T_TOK + slot];
                    bf16_t* rowp = ys0 + (long)(tk & 1) * ysd + (long)(tk >> 1) * DM + u.pn * BM + wc * 32 + 8 * fq;
#pragma unroll
                    for (int bj = 0; bj < 2; ++bj) { const f32x4 v0 = acc[ai][bj][m][0], v1 = acc[ai][bj][m][1];
                        u32x4 w; w.x = cvt_pk_bf16(v0[0], v0[1]); w.y = cvt_pk_bf16(v0[2], v0[3]); w.z = cvt_pk_bf16(v1[0], v1[1]); w.w = cvt_pk_bf16(v1[2], v1[3]);
                        *(u32x4*)(rowp + bj * HALF) = w; }
                }
            }
    }
};
}

template <class L>
__device__ __forceinline__ void transpose_item(const L& ld, int K, bf16_t* WT, int nblk, LAS float* scr, int item, int lane) {
    const int kb = item / nblk, nb = item % nblk, k0 = 64 * kb, n0 = 32 * nb;
    float tv[32];
#pragma unroll
    for (int i = 0; i < 32; ++i) tv[i] = ld(k0 + 2 * i + (lane >> 5), n0 + (lane & 31));
#pragma unroll
    for (int i = 0; i < 32; ++i) scr[(2 * i + (lane >> 5)) * 33 + (lane & 31)] = tv[i];
    LDS_WAIT(); asm volatile("" ::: "memory");
    const int c = lane & 7;
#pragma unroll
    for (int j = 0; j < 4; ++j) { const int n = (lane >> 3) + 8 * j; const LAS float* s = scr + (8 * c) * 33 + n;
        u32x4 o; o.x = cvt_pk_bf16(s[0 * 33], s[1 * 33]); o.y = cvt_pk_bf16(s[2 * 33], s[3 * 33]); o.z = cvt_pk_bf16(s[4 * 33], s[5 * 33]); o.w = cvt_pk_bf16(s[6 * 33], s[7 * 33]);
        *(u32x4*)(WT + (size_t)(n0 + n) * K + k0 + 8 * c) = o; }
    LDS_WAIT(); asm volatile("" ::: "memory");
}
struct LdPlain { const float* W; int ldw; __device__ __forceinline__ float operator()(int k, int n) const { return W[(size_t)k * ldw + n]; } };
struct LdIn0 {
    const float* W;
    __device__ __forceinline__ float operator()(int k, int n) const {
        int col;
        if (n < 1024) { const int G = n >> 5, nn = (n >> 4) & 1, i = n & 15; col = nn * 512 + 16 * G + i; }
        else if (n < 2048) { const int base = (n < 1536) ? 1024 : 1536, p = n - base, G = p >> 5, nn = (p >> 4) & 1, i = p & 15; col = base + 64 * (G >> 1) + 16 * (G & 1) + i + 32 * nn; }
        else col = n;
        return W[(size_t)k * 2560 + col];
    }
};
struct LdGU {
    const float* Wg; const float* Wu;
    __device__ __forceinline__ float operator()(int k, int n) const { const int G = n >> 5, nn = (n >> 4) & 1, i = n & 15;
        const uintptr_t d = (uintptr_t)Wu - (uintptr_t)Wg; const float* p = (const float*)((uintptr_t)Wg + (nn ? d : (uintptr_t)0)); return p[(size_t)k * DFF + 16 * G + i]; }
};
struct LdFoldB {
    const float* pw; const float* ps;
    __device__ __forceinline__ float operator()(int k, int n) const { const int g = k >> 7, d = k & 127, c = n & 127; return ((n >> 7) == g) ? pw[(g * 128 + c) * 128 + d] * ps[g * 128 + d] : 0.f; }
};

struct Frame { LAS unsigned char* lds; int tid, lane, wave, G, vcu; };

__device__ __forceinline__ void p0_prologue(const Frame& F, const Args& a) {
    LAS float* scr = (LAS float*)(F.lds + F.wave * 16384);
    const int gw = F.vcu * NWAVES + F.wave, NGW = F.G * NWAVES;
    unsigned char* ws = a.ws;
    constexpr int I_IN0 = 16 * 80, I_OUT = 16 * 32, I_GU = 16 * 32, I_D = 8 * 32, I_IN1 = 16 * 64;
    constexpr int S0 = I_IN0, S1 = S0 + I_OUT, S2 = S1 + 16 * I_GU, S3 = S2 + 16 * I_D, S4 = S3 + I_IN1, S5 = S4 + I_OUT, S6 = S5 + 16 * I_GU, S7 = S6 + 16 * I_D, S8 = S7 + 8 * 16;
    for (int it = gw; it < S8; it += NGW) {
        if (it < S0) { LdIn0 l{a.in[3]}; transpose_item(l, 1024, (bf16_t*)(ws + WT_IN0), 80, scr, it, F.lane); }
        else if (it < S1) { LdPlain l{a.in[13], 1024}; transpose_item(l, 1024, (bf16_t*)(ws + WT_OUT0), 32, scr, it - S0, F.lane); }
        else if (it < S2) { const int r = it - S1, e = r / I_GU; LdGU l{a.in[16] + (size_t)e * DM * DFF, a.in[17] + (size_t)e * DM * DFF}; transpose_item(l, 1024, (bf16_t*)(ws + WT_GU0) + (size_t)e * 1024 * 1024, 32, scr, r % I_GU, F.lane); }
        else if (it < S3) { const int r = it - S2, e = r / I_D; LdPlain l{a.in[18] + (size_t)e * DFF * DM, 1024}; transpose_item(l, 512, (bf16_t*)(ws + WT_D0) + (size_t)e * 1024 * 512, 32, scr, r % I_D, F.lane); }
        else if (it < S4) { LdPlain l{a.in[21], 2048}; transpose_item(l, 1024, (bf16_t*)(ws + WT_IN1), 64, scr, it - S3, F.lane); }
        else if (it < S5) { const int r = it - S4;
            if (r < 256) { LdPlain l{a.in[24], 1024}; transpose_item(l, 1024, (bf16_t*)(ws + WT_OUT1), 32, scr, r, F.lane); }
            else { LdPlain l{a.in[24] + (size_t)512 * DM, 1024}; transpose_item(l, 512, (bf16_t*)(ws + WT_FA), 32, scr, r - 256, F.lane); } }
        else if (it < S6) { const int r = it - S5, e = r / I_GU; LdGU l{a.in[27] + (size_t)e * DM * DFF, a.in[28] + (size_t)e * DM * DFF}; transpose_item(l, 1024, (bf16_t*)(ws + WT_GU1) + (size_t)e * 1024 * 1024, 32, scr, r % I_GU, F.lane); }
        else if (it < S7) { const int r = it - S6, e = r / I_D; LdPlain l{a.in[29] + (size_t)e * DFF * DM, 1024}; transpose_item(l, 512, (bf16_t*)(ws + WT_D1) + (size_t)e * 1024 * 512, 32, scr, r % I_D, F.lane); }
        else { LdFoldB l{a.in[22], a.in[23]}; transpose_item(l, 512, (bf16_t*)(ws + WT_FB), 16, scr, it - S7, F.lane); }
    }
    { const float* x = a.in[0]; bf16_t* xb = (bf16_t*)(ws + WS_XB); const size_t n8 = (size_t)T_TOK * DM / 8, stride = (size_t)F.G * NTHREADS;
      for (size_t i = (size_t)F.vcu * NTHREADS + F.tid; i < n8; i += stride) { const f32x4 v0 = *(const f32x4*)(x + i * 8), v1 = *(const f32x4*)(x + i * 8 + 4);
          u32x4 w; w.x = cvt_pk_bf16(v0[0], v0[1]); w.y = cvt_pk_bf16(v0[2], v0[3]); w.z = cvt_pk_bf16(v1[0], v1[1]); w.w = cvt_pk_bf16(v1[2], v1[3]); *(u32x4*)(xb + i * 8) = w; } }
    { float2* cs = (float2*)(ws + WS_ROPE);
      for (int i = F.vcu * NTHREADS + F.tid; i < SEQ * 32; i += F.G * NTHREADS) { const int pos = i >> 5, f = i & 31; const float inv = powf(10000.0f, -(float)(2 * f) / 64.0f); float s, c; sincosf((float)pos * inv, &s, &c); cs[i] = make_float2(c, s); } }
}


__device__ __forceinline__ float bflo(unsigned w) { return __uint_as_float(w << 16); }
__device__ __forceinline__ float bfhi(unsigned w) { return __uint_as_float(w & 0xffff0000u); }

__device__ __forceinline__ void ph_ln_router(const Frame& F, const bf16_t* Y, const float* g, const float* bta, const float* rw, const float* rb,
                                             bf16_t* x1b, int* ltok, float* lgate, int* cnt) {
    LAS float* rwT = (LAS float*)F.lds;
    LAS float* lgs = (LAS float*)(F.lds + 65536) + F.wave * 16;
    LAS int* lcnt = (LAS int*)(F.lds + 65536 + 1024);
    LAS int* tinfo = (LAS int*)(F.lds + 65536 + 2048);
    for (int i = F.tid; i < 16 * 1024; i += NTHREADS) { const int c = i >> 4, e = i & 15; rwT[e * 1024 + c] = rw[i]; }
    const int lane = F.lane;
    float gam[16], bet[16];
#pragma unroll
    for (int j = 0; j < 4; ++j) { const f32x4 a = *(const f32x4*)(g + 4 * lane + 256 * j), b = *(const f32x4*)(bta + 4 * lane + 256 * j);
#pragma unroll
        for (int q = 0; q < 4; ++q) { gam[4 * j + q] = a[q]; bet[4 * j + q] = b[q]; } }
    for (int tb = F.vcu; tb < T_TOK / 64; tb += F.G) {
        if (F.tid < 32) lcnt[F.tid] = 0;
        __syncthreads();
        for (int k = 0; k < 8; ++k) {
            const int tl = F.wave * 8 + k, t = tb * 64 + tl;
            float v[16], s = 0.f;
#pragma unroll
            for (int j = 0; j < 4; ++j) { const u32x2 w = *(const u32x2*)(Y + (size_t)t * DM + 4 * lane + 256 * j);
                v[4 * j] = bflo(w.x); v[4 * j + 1] = bfhi(w.x); v[4 * j + 2] = bflo(w.y); v[4 * j + 3] = bfhi(w.y); }
#pragma unroll
            for (int i = 0; i < 16; ++i) s += v[i];
            const float mean = wave_sum(s) * (1.0f / DM);
            float q2 = 0.f;
#pragma unroll
            for (int i = 0; i < 16; ++i) { v[i] -= mean; q2 += v[i] * v[i]; }
            const float rstd = rsqrtf(wave_sum(q2) * (1.0f / DM) + LN_EPS);
#pragma unroll
            for (int i = 0; i < 16; ++i) v[i] = v[i] * rstd * gam[i] + bet[i];
#pragma unroll
            for (int j = 0; j < 4; ++j) { u32x2 w; w.x = cvt_pk_bf16(v[4 * j], v[4 * j + 1]); w.y = cvt_pk_bf16(v[4 * j + 2], v[4 * j + 3]); *(u32x2*)(x1b + (size_t)t * DM + 4 * lane + 256 * j) = w; }
            float lg[16];
#pragma unroll
            for (int e = 0; e < 16; ++e) { float a = 0.f;
#pragma unroll
                for (int j = 0; j < 4; ++j) { const f32x4 w = *(const LAS f32x4*)(rwT + e * 1024 + 4 * lane + 256 * j);
                    a += v[4 * j] * w[0] + v[4 * j + 1] * w[1] + v[4 * j + 2] * w[2] + v[4 * j + 3] * w[3]; }
                lg[e] = a; }
            float r8[8], r4[4], r2[2], r1;
            { const bool up = (lane & 32) != 0;
#pragma unroll
              for (int i = 0; i < 8; ++i) { const float send = up ? lg[i] : lg[i + 8]; const float keep = up ? lg[i + 8] : lg[i]; r8[i] = keep + __shfl_xor(send, 32); } }
            { const bool up = (lane & 16) != 0;
#pragma unroll
              for (int i = 0; i < 4; ++i) { const float send = up ? r8[i] : r8[i + 4]; const float keep = up ? r8[i + 4] : r8[i]; r4[i] = keep + __shfl_xor(send, 16); } }
            { const bool up = (lane & 8) != 0;
#pragma unroll
              for (int i = 0; i < 2; ++i) { const float send = up ? r4[i] : r4[i + 2]; const float keep = up ? r4[i + 2] : r4[i]; r2[i] = keep + __shfl_xor(send, 8); } }
            { const bool up = (lane & 4) != 0; const float send = up ? r2[0] : r2[1]; const float keep = up ? r2[1] : r2[0]; r1 = keep + __shfl_xor(send, 4); }
            r1 += __shfl_xor(r1, 1); r1 += __shfl_xor(r1, 2);
            if ((lane & 3) == 0) lgs[((lane >> 5) & 1) * 8 + ((lane >> 4) & 1) * 4 + ((lane >> 3) & 1) * 2 + ((lane >> 2) & 1)] = r1;
            LDS_WAIT(); asm volatile("" ::: "memory");
            if (lane == 0) {
                float aff[16], sel[16];
#pragma unroll
                for (int e = 0; e < 16; ++e) { aff[e] = 1.0f / (1.0f + expf(-lgs[e])); sel[e] = aff[e] + rb[e]; }
                int gb = 0, bi1 = 0, bi2 = 1; float best = -INFINITY;
#pragma unroll
                for (int gi = 0; gi < 4; ++gi) {
                    int i1 = 0; float v1 = sel[gi * 4];
#pragma unroll
                    for (int kk = 1; kk < 4; ++kk) if (sel[gi * 4 + kk] > v1) { v1 = sel[gi * 4 + kk]; i1 = kk; }
                    int i2 = -1; float v2 = -INFINITY;
#pragma unroll
                    for (int kk = 0; kk < 4; ++kk) if (kk != i1 && sel[gi * 4 + kk] > v2) { v2 = sel[gi * 4 + kk]; i2 = kk; }
                    const float sc = v1 + v2;
                    if (sc > best) { best = sc; gb = gi; bi1 = i1; bi2 = i2; }
                }
                const int e0 = gb * 4 + bi1, e1 = gb * 4 + bi2;
                float a0 = 0.f, a1 = 0.f;
#pragma unroll
                for (int e = 0; e < 16; ++e) { if (e == e0) a0 = aff[e]; if (e == e1) a1 = aff[e]; }
                const float g0 = a0 / (a0 + a1), g1 = a1 / (a0 + a1);
                const int r0 = atomicAdd((int*)(lcnt + e0), 1), r1_ = atomicAdd((int*)(lcnt + e1), 1);
                LAS int* ti = tinfo + tl * 6; ti[0] = e0; ti[1] = r0; ti[2] = e1; ti[3] = r1_; ti[4] = __float_as_int(g0); ti[5] = __float_as_int(g1);
            }
            asm volatile("" ::: "memory");
        }
        __syncthreads();
        if (F.tid < 16) { const int c = lcnt[F.tid]; lcnt[16 + F.tid] = c ? atomicAdd(cnt + 64 * F.tid, c) : 0; }
        __syncthreads();
        if (F.tid < 64) { const LAS int* ti = tinfo + F.tid * 6; const int t = tb * 64 + F.tid;
            const int e0 = ti[0], s0 = lcnt[16 + e0] + ti[1], e1 = ti[2], s1 = lcnt[16 + e1] + ti[3];
            ltok[e0 * T_TOK + s0] = t * 2 + 0; lgate[e0 * T_TOK + s0] = __int_as_float(ti[4]);
            ltok[e1 * T_TOK + s1] = t * 2 + 1; lgate[e1 * T_TOK + s1] = __int_as_float(ti[5]); }
        __syncthreads();
    }
}

__device__ __forceinline__ void ph_ln_ffn(const Frame& F, const bf16_t* x1b, const bf16_t* ys0, const bf16_t* ys1, const float* g, const float* bta, bf16_t* xb_out, float* fout) {
    const int lane = F.lane, gw = F.vcu * NWAVES + F.wave, NGW = F.G * NWAVES;
    float gam[16], bet[16];
#pragma unroll
    for (int j = 0; j < 4; ++j) { const f32x4 a = *(const f32x4*)(g + 4 * lane + 256 * j), b = *(const f32x4*)(bta + 4 * lane + 256 * j);
#pragma unroll
        for (int q = 0; q < 4; ++q) { gam[4 * j + q] = a[q]; bet[4 * j + q] = b[q]; } }
    for (int t = gw; t < T_TOK; t += NGW) {
        float v[16], s = 0.f;
#pragma unroll
        for (int j = 0; j < 4; ++j) { const size_t ix = (size_t)t * DM + 4 * lane + 256 * j;
            const u32x2 a = *(const u32x2*)(x1b + ix), b = *(const u32x2*)(ys0 + ix), c = *(const u32x2*)(ys1 + ix);
            v[4 * j] = ALPHA * bflo(a.x) + bflo(b.x) + bflo(c.x); v[4 * j + 1] = ALPHA * bfhi(a.x) + bfhi(b.x) + bfhi(c.x);
            v[4 * j + 2] = ALPHA * bflo(a.y) + bflo(b.y) + bflo(c.y); v[4 * j + 3] = ALPHA * bfhi(a.y) + bfhi(b.y) + bfhi(c.y); }
#pragma unroll
        for (int i = 0; i < 16; ++i) s += v[i];
        const float mean = wave_sum(s) * (1.0f / DM);
        float q2 = 0.f;
#pragma unroll
        for (int i = 0; i < 16; ++i) { v[i] -= mean; q2 += v[i] * v[i]; }
        const float rstd = rsqrtf(wave_sum(q2) * (1.0f / DM) + LN_EPS);
#pragma unroll
        for (int i = 0; i < 16; ++i) v[i] = v[i] * rstd * gam[i] + bet[i];
#pragma unroll
        for (int j = 0; j < 4; ++j) { const size_t ix = (size_t)t * DM + 4 * lane + 256 * j;
            if (xb_out) { u32x2 w; w.x = cvt_pk_bf16(v[4 * j], v[4 * j + 1]); w.y = cvt_pk_bf16(v[4 * j + 2], v[4 * j + 3]); *(u32x2*)(xb_out + ix) = w; }
            if (fout) *(f32x4*)(fout + ix) = (f32x4){v[4 * j], v[4 * j + 1], v[4 * j + 2], v[4 * j + 3]}; }
    }
}

__device__ __forceinline__ void conv_unit(const Frame& F, int unit, const bf16_t* aglu, const float* cw, const float* cb, const float* g, const float* bta, bf16_t* mix) {
    LAS float* cv = (LAS float*)F.lds;
    const int t0 = unit * 32, cp = F.tid & 255, th = F.tid >> 8, c0 = 2 * cp;
    const int tb = t0 + th * 16, posb = tb & (SEQ - 1);
    float w0[31], w1[31];
#pragma unroll
    for (int w = 0; w < 31; ++w) { const f32x2 x = *(const f32x2*)(cw + w * 512 + c0); w0[w] = x[0]; w1[w] = x[1]; }
    const f32x2 bias = *(const f32x2*)(cb + c0);
    unsigned in[46];
#pragma unroll
    for (int r = 0; r < 46; ++r) { const int p = posb - 30 + r; in[r] = (p >= 0) ? *(const unsigned*)(aglu + (size_t)(tb - 30 + r) * 512 + c0) : 0u; }
    __syncthreads();
#pragma unroll
    for (int t = 0; t < 16; ++t) { float a0 = bias[0], a1 = bias[1];
#pragma unroll
        for (int w = 0; w < 31; ++w) { a0 += bflo(in[t + w]) * w0[w]; a1 += bfhi(in[t + w]) * w1[w]; }
        *(LAS f32x2*)(cv + (th * 16 + t) * 512 + c0) = (f32x2){a0, a1}; }
    __syncthreads();
    const int lane = F.lane;
    const f32x4 g0 = *(const f32x4*)(g + 8 * lane), g1 = *(const f32x4*)(g + 8 * lane + 4), b0 = *(const f32x4*)(bta + 8 * lane), b1 = *(const f32x4*)(bta + 8 * lane + 4);
#pragma unroll
    for (int k = 0; k < 4; ++k) { const int tl = F.wave * 4 + k;
        const f32x4 x0 = *(const LAS f32x4*)(cv + tl * 512 + 8 * lane), x1 = *(const LAS f32x4*)(cv + tl * 512 + 8 * lane + 4);
        float v[8] = {x0[0], x0[1], x0[2], x0[3], x1[0], x1[1], x1[2], x1[3]}, s = 0.f;
#pragma unroll
        for (int i = 0; i < 8; ++i) s += v[i];
        const float mean = wave_sum(s) * (1.0f / 512.0f); float q2 = 0.f;
#pragma unroll
        for (int i = 0; i < 8; ++i) { v[i] -= mean; q2 += v[i] * v[i]; }
        const float rstd = rsqrtf(wave_sum(q2) * (1.0f / 512.0f) + LN_EPS);
        const float gg[8] = {g0[0], g0[1], g0[2], g0[3], g1[0], g1[1], g1[2], g1[3]}, bb[8] = {b0[0], b0[1], b0[2], b0[3], b1[0], b1[1], b1[2], b1[3]};
#pragma unroll
        for (int i = 0; i < 8; ++i) { const float y = v[i] * rstd * gg[i] + bb[i]; v[i] = y * sigmoidf_(y); }
        u32x4 w; w.x = cvt_pk_bf16(v[0], v[1]); w.y = cvt_pk_bf16(v[2], v[3]); w.z = cvt_pk_bf16(v[4], v[5]); w.w = cvt_pk_bf16(v[6], v[7]);
        *(u32x4*)(mix + (size_t)(t0 + tl) * DM + 8 * lane) = w; }
}

__device__ __forceinline__ void pool_unit(const Frame& F, int unit, const bf16_t* P1, bf16_t* mix) {
    const int cp = F.tid & 255, th = F.tid >> 8, c0 = 2 * cp, grp = cp >> 6, win = 2 << grp;
    const int tb = unit * 64 + th * 32, posb = tb & (SEQ - 1);
    unsigned in[47];
#pragma unroll
    for (int r = 0; r < 47; ++r) { const int p = posb - 15 + r; in[r] = (p >= 0) ? *(const unsigned*)(P1 + (size_t)(tb - 15 + r) * 2048 + 1536 + c0) : 0u; }
#pragma unroll
    for (int t = 0; t < 32; ++t) { float s0 = 0.f, s1 = 0.f; const int pos = posb + t;
#pragma unroll
        for (int i = 0; i < 16; ++i) if (i < win) { s0 += bflo(in[15 + t - i]); s1 += bfhi(in[15 + t - i]); }
        const int cn = (pos + 1 < win) ? pos + 1 : win; const float ic = 1.0f / (float)cn;
        const float o0 = s0 * ic - bflo(in[15 + t]), o1 = s1 * ic - bfhi(in[15 + t]);
        *(unsigned*)(mix + (size_t)(tb + t) * DM + 512 + c0) = cvt_pk_bf16(o0, o1); }
}


namespace att {
typedef short v4i16 __attribute__((ext_vector_type(4)));
__device__ __forceinline__ int crow(int r, int hi) { return (r & 3) + 8 * (r >> 2) + 4 * hi; }
__device__ __forceinline__ v4i16 vtr(const LAS unsigned char* p) { return __builtin_amdgcn_ds_read_tr16_b64_v4i16((LAS v4i16*)p); }
__device__ __forceinline__ bf16x8 vfrag(const LAS unsigned char* p) { const v4i16 lo = vtr(p), hi = vtr(p + 512); return (bf16x8){lo[0], lo[1], lo[2], lo[3], hi[0], hi[1], hi[2], hi[3]}; }
__device__ __forceinline__ float ex2(float x) { return __builtin_amdgcn_exp2f(x); }
__device__ __forceinline__ float lg2(float x) { return __builtin_amdgcn_logf(x); }
__device__ __forceinline__ float partner32(float x, int hb) { auto rr = __builtin_amdgcn_permlane32_swap(__float_as_uint(x), __float_as_uint(x), false, false); return __uint_as_float(hb ? rr[0] : rr[1]); }
__device__ __forceinline__ bf16x8 pack8(const f32x16& p, int b) { u32x4 w; w.x = cvt_pk_bf16(p[b], p[b + 1]); w.y = cvt_pk_bf16(p[b + 2], p[b + 3]); w.z = cvt_pk_bf16(p[b + 4], p[b + 5]); w.w = cvt_pk_bf16(p[b + 6], p[b + 7]); return __builtin_bit_cast(bf16x8, w); }
#define GLDS16(src, dst) __builtin_amdgcn_global_load_lds((const unsigned*)(src), (LAS unsigned*)(dst), 16, 0, 0)

__device__ __forceinline__ void diff_unit(const Frame& F, int b, int h, int qblk, const bf16_t* Q, const bf16_t* K, const bf16_t* V, float lam, const float* sg, bf16_t* mix) {
    const int lane = F.lane, wid = F.wave, r32 = lane & 31, hb = lane >> 5, st = wid >> 2, ww = wid & 3;
    const size_t row0 = (size_t)b * SEQ;
    const int q0 = qblk * 128, qw0 = q0 + 32 * ww, qrow = qw0 + r32, nt = 2 * qblk + 2;
    bf16x8 qf[4];
    { const bf16_t* qp = Q + (row0 + qrow) * 512 + 128 * h + 64 * st + 8 * hb;
#pragma unroll
      for (int d0 = 0; d0 < 4; ++d0) qf[d0] = *(const bf16x8*)(qp + 16 * d0); }
    const bf16_t* src0; int dst0, sstep, dstep;
    if (wid < 4) { src0 = K + (row0 + lane) * 512 + 128 * h + 64 * (wid >> 1) + 32 * (wid & 1); sstep = 8; dst0 = (wid >> 1) * 8192 + (wid & 1) * 4096; dstep = 1024; }
    else { src0 = V + (row0 + 8 * (lane >> 5) + ((lane >> 2) & 7)) * 512 + 128 * h + 32 * (wid - 4) + 8 * (lane & 3); sstep = 16 * 512; dst0 = 16384 + (wid - 4) * 4096; dstep = 1024; }
#define DIFF_ISSUE(t, stg) do { const bf16_t* s_ = src0 + (size_t)(t) * 64 * 512; LAS unsigned char* d_ = F.lds + (stg) * 32768 + dst0; \
        _Pragma("unroll") for (int i_ = 0; i_ < 4; ++i_) GLDS16(s_ + (size_t)i_ * sstep, d_ + i_ * dstep); } while (0)
    f32x16 o[4];
#pragma unroll
    for (int d = 0; d < 4; ++d)
#pragma unroll
        for (int r = 0; r < 16; ++r) o[d][r] = 0.f;
    float m = -INFINITY, l = 0.f;
    const int vlane = (4 * hb + ((lane & 15) >> 2)) * 64 + ((lane >> 4) & 1) * 32 + (lane & 3) * 8;
    DIFF_ISSUE(0, 0);
    for (int t = 0; t < nt; ++t) {
        VM_WAIT(); __syncthreads();
        if (t + 1 < nt) DIFF_ISSUE(t + 1, (t + 1) & 1);
        const LAS unsigned char* sb = F.lds + (t & 1) * 32768;
        const int kv0 = 64 * t;
        if (kv0 <= qw0 + 31) {
            f32x16 p0, p1;
#pragma unroll
            for (int r = 0; r < 16; ++r) { p0[r] = 0.f; p1[r] = 0.f; }
            const LAS unsigned char* kb = sb + st * 8192 + hb * 1024 + r32 * 16;
#pragma unroll
            for (int d0 = 0; d0 < 4; ++d0) { const bf16x8 a0 = *(const LAS bf16x8*)(kb + d0 * 2048), a1 = *(const LAS bf16x8*)(kb + d0 * 2048 + 512);
                p0 = __builtin_amdgcn_mfma_f32_32x32x16_bf16(a0, qf[d0], p0, 0, 0, 0); p1 = __builtin_amdgcn_mfma_f32_32x32x16_bf16(a1, qf[d0], p1, 0, 0, 0); }
            if (kv0 + 63 > qw0) {
#pragma unroll
                for (int r = 0; r < 16; ++r) { const int kvg = kv0 + crow(r, hb); if (kvg > qrow) p0[r] = -INFINITY; if (kvg + 32 > qrow) p1[r] = -INFINITY; }
            }
            float mx = fmaxf(p0[0], p1[0]);
#pragma unroll
            for (int r = 1; r < 16; ++r) mx = fmaxf(mx, fmaxf(p0[r], p1[r]));
            mx = fmaxf(mx, partner32(mx, hb));
            const float mn = fmaxf(m, mx), alpha = ex2(m - mn); m = mn;
            float ls = 0.f;
#pragma unroll
            for (int r = 0; r < 16; ++r) { p0[r] = ex2(p0[r] - mn); p1[r] = ex2(p1[r] - mn); ls += p0[r] + p1[r]; }
            l = l * alpha + ls;
#pragma unroll
            for (int d = 0; d < 4; ++d)
#pragma unroll
                for (int r = 0; r < 16; ++r) o[d][r] *= alpha;
            const bf16x8 pf0 = pack8(p0, 0), pf1 = pack8(p0, 8), pf2 = pack8(p1, 0), pf3 = pack8(p1, 8);
            const LAS unsigned char* vb = sb + 16384 + vlane;
#pragma unroll
            for (int d = 0; d < 4; ++d) {
                o[d] = __builtin_amdgcn_mfma_f32_32x32x16_bf16(vfrag(vb + d * 4096), pf0, o[d], 0, 0, 0);
                o[d] = __builtin_amdgcn_mfma_f32_32x32x16_bf16(vfrag(vb + d * 4096 + 1024), pf1, o[d], 0, 0, 0);
                o[d] = __builtin_amdgcn_mfma_f32_32x32x16_bf16(vfrag(vb + d * 4096 + 2048), pf2, o[d], 0, 0, 0);
                o[d] = __builtin_amdgcn_mfma_f32_32x32x16_bf16(vfrag(vb + d * 4096 + 3072), pf3, o[d], 0, 0, 0);
            }
        }
    }
#undef DIFF_ISSUE
    { const float lt = l + partner32(l, hb), inv = 1.0f / lt;
#pragma unroll
      for (int d = 0; d < 4; ++d)
#pragma unroll
          for (int r = 0; r < 16; ++r) o[d][r] *= inv; }
    __syncthreads();
    LAS float* xb = (LAS float*)F.lds + ww * 4096;
    if (st == 1) {
#pragma unroll
        for (int d = 0; d < 4; ++d)
#pragma unroll
            for (int r = 0; r < 16; ++r) xb[(d * 16 + r) * 64 + lane] = o[d][r];
    }
    __syncthreads();
    if (st == 0) {
        float ss = 0.f;
#pragma unroll
        for (int d = 0; d < 4; ++d)
#pragma unroll
            for (int r = 0; r < 16; ++r) { const float v = o[d][r] - lam * xb[(d * 16 + r) * 64 + lane]; o[d][r] = v; ss += v * v; }
        ss += partner32(ss, hb);
        const float rs = rsqrtf(ss * (1.0f / 128.0f) + RMS_EPS) * (1.0f - LAM_INIT0);
        bf16_t* op = mix + (row0 + qrow) * DM + 512 + 128 * h;
#pragma unroll
        for (int d = 0; d < 4; ++d)
#pragma unroll
            for (int g4 = 0; g4 < 4; ++g4) { const int dd = 32 * d + 8 * g4 + 4 * hb; const f32x4 gv = *(const f32x4*)(sg + dd);
                pg8::st_bf16x4(op + dd, (f32x4){o[d][4 * g4] * rs * gv[0], o[d][4 * g4 + 1] * rs * gv[1], o[d][4 * g4 + 2] * rs * gv[2], o[d][4 * g4 + 3] * rs * gv[3]}); }
    }
    __syncthreads();
}

__device__ __forceinline__ void sb_unit(const Frame& F, int b, int h, int qblk, const bf16_t* P1, bf16_t* mix) {
    const int lane = F.lane, wid = F.wave, r32 = lane & 31, hb = lane >> 5;
    const size_t row0 = (size_t)b * SEQ;
    const int q0 = qblk * 256, qw0 = q0 + 32 * wid, qrow = qw0 + r32, nt = 4 * qblk + 4;
    bf16x8 qf[4];
    { const bf16_t* qp = P1 + (row0 + qrow) * 2048 + 64 * h + 8 * hb;
#pragma unroll
      for (int d0 = 0; d0 < 4; ++d0) qf[d0] = *(const bf16x8*)(qp + 16 * d0); }
    const bf16_t* src0; int dst0, sstep;
    if (wid < 4) { src0 = P1 + (row0 + lane) * 2048 + 512 + 64 * h + 16 * wid; sstep = 8; dst0 = wid * 2048; }
    else { const int w4 = wid - 4; src0 = P1 + (row0 + 32 * (w4 & 1) + 8 * (lane >> 5) + ((lane >> 2) & 7)) * 2048 + 1024 + 64 * h + 32 * (w4 >> 1) + 8 * (lane & 3); sstep = 16 * 2048; dst0 = 8192 + (w4 >> 1) * 4096 + (w4 & 1) * 2048; }
#define SB_ISSUE(t, stg) do { const bf16_t* s_ = src0 + (size_t)(t) * 64 * 2048; LAS unsigned char* d_ = F.lds + (stg) * 16384 + dst0; \
        GLDS16(s_, d_); GLDS16(s_ + sstep, d_ + 1024); } while (0)
    f32x16 o[2];
#pragma unroll
    for (int d = 0; d < 2; ++d)
#pragma unroll
        for (int r = 0; r < 16; ++r) o[d][r] = 0.f;
    float carry = 0.f;
    const int vlane = (4 * hb + ((lane & 15) >> 2)) * 64 + ((lane >> 4) & 1) * 32 + (lane & 3) * 8;
    LAS int* flags = (LAS int*)(F.lds + 32768);
    if (lane == 0) { flags[wid] = 0; flags[8 + wid] = 0; }
    SB_ISSUE(nt - 1, 0);
    for (int it = 0; it < nt; ++it) {
        const int t = nt - 1 - it;
        VM_WAIT(); __syncthreads();
        if (it > 0) { const LAS int* fl = flags + ((it - 1) & 1) * 8; const int alld = fl[0] & fl[1] & fl[2] & fl[3] & fl[4] & fl[5] & fl[6] & fl[7]; if (alld) break; }
        if (t > 0) SB_ISSUE(t - 1, (it + 1) & 1);
        const LAS unsigned char* sb = F.lds + (it & 1) * 16384;
        const int kv0 = 64 * t;
        if (kv0 <= qw0) {
            f32x16 p0, p1;
#pragma unroll
            for (int r = 0; r < 16; ++r) { p0[r] = 0.f; p1[r] = 0.f; }
            const LAS unsigned char* kb = sb + hb * 1024 + r32 * 16;
#pragma unroll
            for (int d0 = 0; d0 < 4; ++d0) { const bf16x8 a0 = *(const LAS bf16x8*)(kb + d0 * 2048), a1 = *(const LAS bf16x8*)(kb + d0 * 2048 + 512);
                p0 = __builtin_amdgcn_mfma_f32_32x32x16_bf16(a0, qf[d0], p0, 0, 0, 0); p1 = __builtin_amdgcn_mfma_f32_32x32x16_bf16(a1, qf[d0], p1, 0, 0, 0); }
            const bool diag = (kv0 + 63 >= qw0);
            f32x16 l0, l1;
#pragma unroll
            for (int r = 0; r < 16; ++r) {
                { const float z = p0[r], sp = fmaxf(z, 0.f) + lg2(1.0f + ex2(-fabsf(z))); const bool ok = !diag || (kv0 + crow(r, hb) < qrow); l0[r] = ok ? -sp : 0.f; p0[r] = ok ? z - sp : -INFINITY; }
                { const float z = p1[r], sp = fmaxf(z, 0.f) + lg2(1.0f + ex2(-fabsf(z))); const bool ok = !diag || (kv0 + 32 + crow(r, hb) < qrow); l1[r] = ok ? -sp : 0.f; p1[r] = ok ? z - sp : -INFINITY; }
            }
            float Tq[8], Tp[8], U[8], SU[8];
#pragma unroll
            for (int g4 = 0; g4 < 4; ++g4) { Tq[g4] = (l0[4 * g4] + l0[4 * g4 + 1]) + (l0[4 * g4 + 2] + l0[4 * g4 + 3]); Tq[4 + g4] = (l1[4 * g4] + l1[4 * g4 + 1]) + (l1[4 * g4 + 2] + l1[4 * g4 + 3]); }
#pragma unroll
            for (int k = 0; k < 8; ++k) { Tp[k] = partner32(Tq[k], hb); U[k] = Tq[k] + Tp[k]; }
            SU[7] = 0.f;
#pragma unroll
            for (int k = 6; k >= 0; --k) SU[k] = SU[k + 1] + U[k + 1];
#pragma unroll
            for (int k = 0; k < 8; ++k) {
                const float base = carry + SU[k] + (hb ? 0.f : Tp[k]);
                if (k < 4) { const int q = 4 * k; const float s3 = base, s2 = s3 + l0[q + 3], s1 = s2 + l0[q + 2], s0 = s1 + l0[q + 1];
                    p0[q] = ex2(p0[q] + s0); p0[q + 1] = ex2(p0[q + 1] + s1); p0[q + 2] = ex2(p0[q + 2] + s2); p0[q + 3] = ex2(p0[q + 3] + s3); }
                else { const int q = 4 * (k - 4); const float s3 = base, s2 = s3 + l1[q + 3], s1 = s2 + l1[q + 2], s0 = s1 + l1[q + 1];
                    p1[q] = ex2(p1[q] + s0); p1[q + 1] = ex2(p1[q + 1] + s1); p1[q + 2] = ex2(p1[q + 2] + s2); p1[q + 3] = ex2(p1[q + 3] + s3); }
            }
            carry += SU[0] + U[0];
            { const int dn = __all(carry < -180.0f) ? 1 : 0; if (lane == 0) flags[(it & 1) * 8 + wid] = dn; }
            const bf16x8 pf0 = pack8(p0, 0), pf1 = pack8(p0, 8), pf2 = pack8(p1, 0), pf3 = pack8(p1, 8);
            const LAS unsigned char* vb = sb + 8192 + vlane;
#pragma unroll
            for (int d = 0; d < 2; ++d) {
                o[d] = __builtin_amdgcn_mfma_f32_32x32x16_bf16(vfrag(vb + d * 4096), pf0, o[d], 0, 0, 0);
                o[d] = __builtin_amdgcn_mfma_f32_32x32x16_bf16(vfrag(vb + d * 4096 + 1024), pf1, o[d], 0, 0, 0);
                o[d] = __builtin_amdgcn_mfma_f32_32x32x16_bf16(vfrag(vb + d * 4096 + 2048), pf2, o[d], 0, 0, 0);
                o[d] = __builtin_amdgcn_mfma_f32_32x32x16_bf16(vfrag(vb + d * 4096 + 3072), pf3, o[d], 0, 0, 0);
            }
        }
    }
#undef SB_ISSUE
    bf16_t* op = mix + (row0 + qrow) * DM + 64 * h;
#pragma unroll
    for (int d = 0; d < 2; ++d)
#pragma unroll
        for (int g4 = 0; g4 < 4; ++g4) pg8::st_bf16x4(op + 32 * d + 8 * g4 + 4 * hb, (f32x4){o[d][4 * g4], o[d][4 * g4 + 1], o[d][4 * g4 + 2], o[d][4 * g4 + 3]});
    __syncthreads();
}
#undef GLDS16
}

enum Phase { PH_PRO = 0, PH_IN0 = 1, PH_MIX0 = 2, PH_OUT0 = 3, PH_LN0 = 4, PH_GU0 = 5, PH_DN0 = 6, PH_FFN0 = 7, PH_IN1 = 8, PH_MIX1 = 9, PH_OUT1 = 10, PH_LN1 = 11, PH_GU1 = 12, PH_DN1 = 13, PH_FFN1 = 14, PH_N = 15 };


#define XB_TMO      128
#define XB_XCNT(j)  (256  + 64 * (j))
#define XB_XSUB(j)  (1280 + 64 * (j))
#define XB_XGEN(j)  (2304 + 64 * (j))
#define XB_TOP      3328
#define XB_TOPGEN   3392
#define XCD_BAR_WORDS 3456
#define XB_SPIN_CAP (1u << 18)
constexpr int CW_BAR = 4096;
__device__ __forceinline__ unsigned xb_ld(unsigned* p)              { return __hip_atomic_load(p, __ATOMIC_RELAXED, __HIP_MEMORY_SCOPE_AGENT); }
__device__ __forceinline__ unsigned xb_add(unsigned* p, unsigned v) { return __hip_atomic_fetch_add(p, v, __ATOMIC_RELAXED, __HIP_MEMORY_SCOPE_AGENT); }
__device__ __forceinline__ unsigned xb_xcc_id() { return (unsigned)__builtin_amdgcn_s_getreg((3 << 11) | 20) & 0xFu; }
#define XB_SPIN(cond, bar) do { unsigned _sp = 0; while (cond) { __builtin_amdgcn_s_sleep(1); \
    if ((++_sp & 255u) == 0u) { if (xb_ld(&(bar)[XB_TMO])) break; if (_sp > XB_SPIN_CAP) { atomicAdd(&(bar)[XB_TMO], 1u); break; } } } } while (0)
struct XcdBarrier { unsigned* bar; unsigned x; volatile LAS unsigned* st; };
__device__ __forceinline__ XcdBarrier xcd_barrier_post(unsigned* bar, volatile LAS unsigned* st) {
    XcdBarrier b; b.bar = bar; b.x = xb_xcc_id(); b.st = st;
    if (threadIdx.x == 0) (void)xb_add(&bar[XB_XCNT(b.x)], 1u);
    return b;
}
__device__ __forceinline__ void xcd_barrier_complete(unsigned* bar, unsigned x, unsigned& nloc, unsigned& nx) {
    const unsigned G = gridDim.x * gridDim.y * gridDim.z;
    unsigned sum, cnt, mine, sp = 0u;
    for (;;) {
        sum = 0u; cnt = 0u; mine = 0u;
#pragma unroll
        for (unsigned j = 0; j < 16; ++j) { const unsigned c = xb_ld(&bar[XB_XCNT(j)]); sum += c; cnt += (c > 0u) ? 1u : 0u; mine = (j == x) ? c : mine; }
        if (sum == G) break;
        __builtin_amdgcn_s_sleep(1);
        if ((++sp & 255u) == 0u) { if (xb_ld(&bar[XB_TMO])) break; if (sp > XB_SPIN_CAP) { atomicAdd(&bar[XB_TMO], 1u); break; } }
    }
    nloc = mine > 0u ? mine : 1u; nx = cnt > 0u ? cnt : 1u;
}
__device__ __forceinline__ void xcd_barrier(const XcdBarrier& b) {
    asm volatile("s_waitcnt vmcnt(0)" ::: "memory");
    __syncthreads();
    if (threadIdx.x == 0) {
        unsigned* bar = b.bar;
        __builtin_amdgcn_s_waitcnt(0);
        unsigned nloc = b.st[0], nx = b.st[1];
        if (nloc == 0u) { xcd_barrier_complete(bar, b.x, nloc, nx); b.st[0] = nloc; b.st[1] = nx; }
        const unsigned old = xb_add(&bar[XB_XSUB(b.x)], 1u);
        const unsigned gen = old / nloc;
        if (old + 1u == (gen + 1u) * nloc) {
            __builtin_amdgcn_fence(__ATOMIC_RELEASE, "agent");
            asm volatile("s_waitcnt vmcnt(0)" ::: "memory");
            const unsigned og = xb_add(&bar[XB_TOP], 1u);
            const unsigned tg = og / nx;
            if (og + 1u == (tg + 1u) * nx) xb_add(&bar[XB_TOPGEN], 1u);
            else XB_SPIN(xb_ld(&bar[XB_TOPGEN]) == tg, bar);
            __builtin_amdgcn_fence(__ATOMIC_ACQUIRE, "agent");
            xb_add(&bar[XB_XGEN(b.x)], 1u);
            asm volatile("s_waitcnt vmcnt(0)" ::: "memory");
        } else {
            XB_SPIN(xb_ld(&bar[XB_XGEN(b.x)]) == gen, bar);
            __builtin_amdgcn_fence(__ATOMIC_ACQUIRE, "agent");
            asm volatile("s_waitcnt vmcnt(0)" ::: "memory");
        }
    }
    __syncthreads();
}

__global__ void __launch_bounds__(NTHREADS, 2) mk_fwd(Args args) {
    extern __shared__ __attribute__((aligned(16))) unsigned char lds_raw[];
    Frame F; F.lds = (LAS unsigned char*)lds_raw; F.tid = threadIdx.x; F.lane = F.tid & 63; F.wave = __builtin_amdgcn_readfirstlane(F.tid >> 6);
    F.G = gridDim.x; { const int bx = blockIdx.x; F.vcu = (F.G % 8 == 0) ? (bx % 8) * (F.G / 8) + bx / 8 : bx; }
    unsigned char* ws = args.ws;
    const int lo = args.ph_lo, hi = args.ph_hi;
    if (F.tid < 128) ((LAS unsigned*)(F.lds + MISC_OFF))[F.tid] = 0u;
    __syncthreads();
    XcdBarrier bar; bar.bar = (unsigned*)(ws + WS_CTL) + CW_BAR; bar.x = 0; bar.st = nullptr;
    if (hi - lo > 1) bar = xcd_barrier_post((unsigned*)(ws + WS_CTL) + CW_BAR, (volatile LAS unsigned*)(F.lds + MISC_OFF + 256));
#define IN(k) (lo <= (k) && (k) < hi)
#define SEAM(k) do { if (IN(k) && IN((k) + 1)) xcd_barrier(bar); } while (0)
    bf16_t* XB = (bf16_t*)(ws + WS_XB); bf16_t* PBUF = (bf16_t*)(ws + WS_PBUF); bf16_t* MIX = (bf16_t*)(ws + WS_MIX); bf16_t* X1B = (bf16_t*)(ws + WS_X1B);
    int* ltok = (int*)(ws + WS_LTOK); float* lgate = (float*)(ws + WS_LGATE); int* cntw = (int*)(ws + WS_CTL) + CW_CNT;
    LAS int* tab = (LAS int*)(F.lds + MISC_OFF);
#define MOE_TABLE(LAYER) do { if (F.tid == 0) { const int* cg = cntw + 1024 * (LAYER); int p = 0, r = 0; \
        for (int e = 0; e < 16; ++e) { const int c = cg[64 * e]; tab[e] = c; tab[16 + e] = p; tab[33 + e] = r; p += (c + 255) >> 8; r += c; } tab[32] = p; tab[49] = r; } \
        __syncthreads(); } while (0)

    if (IN(PH_PRO)) { p0_prologue(F, args); }
    SEAM(PH_PRO);
    if (IN(PH_IN0)) {
        pg8::DenseSched S; S.init(XB, (const bf16_t*)(ws + WT_IN0), T_TOK, 2560, 1024, F.G, (int)blockIdx.x);
        pg8::EpiIn0F E{PBUF, (const float2*)(ws + WS_ROPE)};
        pg8::gemm_phase<pg8::EpiIn0F, pg8::DenseSched, false, true>(F.lds, 1024, S, E);
        { pg8::DenseSched S2; S2.init((const bf16_t*)(ws + WT_FA), (const bf16_t*)(ws + WT_FB), 1024, 512, 512, 8, (int)blockIdx.x - (F.G - 8));
          if ((int)blockIdx.x >= F.G - 8) { pg8::EpiPlainF E2{(bf16_t*)(ws + WT_OUT1) + 512, 1024, 0, 1.0f};
              pg8::gemm_phase<pg8::EpiPlainF, pg8::DenseSched, false, true>(F.lds, 512, S2, E2); } }
    }
    SEAM(PH_IN0);
    if (IN(PH_MIX0)) {
        for (int u = F.vcu; u < T_TOK / 32; u += F.G) conv_unit(F, u, PBUF, args.in[4], args.in[5], args.in[6], args.in[7], MIX);
        __syncthreads();
        const float d1 = wave_sum(args.in[8][F.lane] * args.in[9][F.lane]), d2 = wave_sum(args.in[10][F.lane] * args.in[11][F.lane]);
        const float lam = expf(d1) - expf(d2) + LAM_INIT0;
        for (int p = F.vcu; p < 256; p += F.G) { const int bh = p >> 3, sidx = p & 7;
            att::diff_unit(F, bh >> 2, bh & 3, 15 - sidx, PBUF + (size_t)T_TOK * 512, PBUF + (size_t)2 * T_TOK * 512, PBUF + (size_t)3 * T_TOK * 512, lam, args.in[12], MIX);
            att::diff_unit(F, bh >> 2, bh & 3, sidx, PBUF + (size_t)T_TOK * 512, PBUF + (size_t)2 * T_TOK * 512, PBUF + (size_t)3 * T_TOK * 512, lam, args.in[12], MIX); }
    }
    SEAM(PH_MIX0);
    if (IN(PH_OUT0)) {
        pg8::DenseSched S; S.init(MIX, (const bf16_t*)(ws + WT_OUT0), T_TOK, 1024, 1024, F.G, (int)blockIdx.x);
        pg8::EpiResF E{PBUF, XB};
        pg8::gemm_phase<pg8::EpiResF, pg8::DenseSched, false, true>(F.lds, 1024, S, E);
    }
    SEAM(PH_OUT0);
    if (IN(PH_LN0)) ph_ln_router(F, PBUF, args.in[14], args.in[15], args.in[1], args.in[2], X1B, ltok, lgate, cntw);
    SEAM(PH_LN0);
    if (IN(PH_GU0) || IN(PH_DN0)) MOE_TABLE(0);
    if (IN(PH_GU0)) { pg8::MoeSched S{X1B, (const bf16_t*)(ws + WT_GU0), ltok, tab, 1024, 4, F.G, (int)blockIdx.x, true};
        pg8::EpiGUF E{PBUF, lgate};
        pg8::gemm_phase<pg8::EpiGUF, pg8::MoeSched, true, true>(F.lds, 1024, S, E); }
    SEAM(PH_GU0);
    if (IN(PH_DN0)) { pg8::MoeSched S{PBUF, (const bf16_t*)(ws + WT_D0), ltok, tab, 512, 4, F.G, (int)blockIdx.x, false};
        pg8::EpiDownF E{MIX, (long)(XB - MIX), ltok};
        pg8::gemm_phase<pg8::EpiDownF, pg8::MoeSched, false, true>(F.lds, 512, S, E); }
    SEAM(PH_DN0);
    if (IN(PH_FFN0)) ph_ln_ffn(F, X1B, MIX, XB, args.in[19], args.in[20], XB, nullptr);
    SEAM(PH_FFN0);
    if (IN(PH_IN1)) {
        pg8::DenseSched S; S.init(XB, (const bf16_t*)(ws + WT_IN1), T_TOK, 2048, 1024, F.G, (int)blockIdx.x);
        pg8::EpiPlainF E{PBUF, 2048, 512, QSCALE};
        pg8::gemm_phase<pg8::EpiPlainF, pg8::DenseSched, false, true>(F.lds, 1024, S, E);
    }
    SEAM(PH_IN1);
    if (IN(PH_MIX1)) {
        for (int u = F.vcu; u < T_TOK / 64; u += F.G) pool_unit(F, u, PBUF, MIX);
        for (int p = F.vcu; p < 256; p += F.G) { const int bh = p >> 2, sidx = p & 3;
            att::sb_unit(F, bh >> 3, bh & 7, 7 - sidx, PBUF, MIX);
            att::sb_unit(F, bh >> 3, bh & 7, sidx, PBUF, MIX); }
    }
    SEAM(PH_MIX1);
    if (IN(PH_OUT1)) {
        pg8::DenseSched S; S.init(MIX, (const bf16_t*)(ws + WT_OUT1), T_TOK, 1024, 1024, F.G, (int)blockIdx.x);
        pg8::EpiResF E{PBUF, XB};
        pg8::gemm_phase<pg8::EpiResF, pg8::DenseSched, false, true>(F.lds, 1024, S, E);
    }
    SEAM(PH_OUT1);
    if (IN(PH_LN1)) ph_ln_router(F, PBUF, args.in[25], args.in[26], args.in[1], args.in[2], X1B, ltok, lgate, cntw + 1024);
    SEAM(PH_LN1);
    if (IN(PH_GU1) || IN(PH_DN1)) MOE_TABLE(1);
    if (IN(PH_GU1)) { pg8::MoeSched S{X1B, (const bf16_t*)(ws + WT_GU1), ltok, tab, 1024, 4, F.G, (int)blockIdx.x, true};
        pg8::EpiGUF E{PBUF, lgate};
        pg8::gemm_phase<pg8::EpiGUF, pg8::MoeSched, true, true>(F.lds, 1024, S, E); }
    SEAM(PH_GU1);
    if (IN(PH_DN1)) { pg8::MoeSched S{PBUF, (const bf16_t*)(ws + WT_D1), ltok, tab, 512, 4, F.G, (int)blockIdx.x, false};
        pg8::EpiDownF E{MIX, (long)(XB - MIX), ltok};
        pg8::gemm_phase<pg8::EpiDownF, pg8::MoeSched, false, true>(F.lds, 512, S, E); }
    SEAM(PH_DN1);
    if (IN(PH_FFN1)) ph_ln_ffn(F, X1B, MIX, XB, args.in[30], args.in[31], nullptr, args.out);
#undef IN
#undef SEAM
#undef MOE_TABLE
}

extern "C" void kernel_launch(void* const* d_in, const int* in_sizes, int n_in, void* d_out, int out_size, void* d_ws, size_t ws_size, hipStream_t stream) {
    if (n_in != 32 || ws_size < WS_END || out_size != T_TOK * DM) { fprintf(stderr, "kernel_launch: unexpected problem (n_in %d ws %zu out %d)\n", n_in, ws_size, out_size); return; }
    static int grid = 0;
    if (grid == 0) {
        int dev = 0, cus = 0;
        if (hipGetDevice(&dev) != hipSuccess || hipDeviceGetAttribute(&cus, hipDeviceAttributeMultiprocessorCount, dev) != hipSuccess) { grid = -1; return; }
        if (hipFuncSetAttribute((const void*)mk_fwd, hipFuncAttributeMaxDynamicSharedMemorySize, LDS_BYTES) != hipSuccess) { fprintf(stderr, "hipFuncSetAttribute failed\n"); grid = -1; return; }
        grid = cus;
    }
    if (grid < 0) return;
    const float* const* in = (const float* const*)d_in;
    unsigned char* ws = (unsigned char*)d_ws;
    (void)hipMemsetAsync(ws + WS_CTL, 0, 1 * MiB, stream);
    int* ctl = (int*)(ws + WS_CTL);
    float2* rope = (float2*)(ws + WS_ROPE);
    int4* topk = (int4*)(ws + WS_TOPK);
    int* ltok = (int*)(ws + WS_LTOK); float* lgate = (float*)(ws + WS_LGATE);
    float* wfold = (float*)(ws + WS_WFOLD);
    bf16_t* XB = (bf16_t*)(ws + WS_XB); bf16_t* PBUF = (bf16_t*)(ws + WS_PBUF); bf16_t* MIX = (bf16_t*)(ws + WS_MIX); bf16_t* X1B = (bf16_t*)(ws + WS_X1B);
    bf16_t* Y = PBUF; bf16_t* YS0 = MIX; bf16_t* YS1 = XB;
    Args a{};
    for (int i = 0; i < 32; ++i) a.in[i] = in[i];
    a.out = (float*)d_out; a.ws = ws;
    auto phases = [&](int lo, int hi) { a.ph_lo = lo; a.ph_hi = hi; hipLaunchKernelGGL(mk_fwd, dim3(grid), dim3(NTHREADS), LDS_BYTES, stream, a); };
    (void)rope; (void)wfold; (void)topk; (void)ltok; (void)lgate; (void)ctl; (void)Y; (void)YS0; (void)YS1; (void)X1B; (void)MIX; (void)PBUF; (void)XB;

    phases(PH_PRO, PH_N);
#ifdef PROBE_LIST
    { static const int pl[] = {PROBE_LIST}; for (int r = 0; r < PROBE_REP; ++r) for (int k : pl) phases(k, k + 1); }
#endif
}
```
